# Optimizing an MI355X kernel written in HIP

```python
import jax, jax.numpy as jnp
from jax import lax
import numpy as np

D_MODEL = 1024
BATCH = 16
SEQ = 256
DEPTH = 2
DEC_BATCH = 8
DEC_SEQ = 2048
PAST_LEN = 512

GRID_W = 64
CONV_W = D_MODEL // 2
DN_HEADS = 4
DK = 128
DV = 128
QK_W = DN_HEADS * DK
V_W = DN_HEADS * DV
D_MIX = CONV_W + V_W
D_FF = ((8 * D_MODEL // 3 + 127) // 128) * 128
CHUNK = 64
EPS = 1e-6
IN_COLS = 3 * CONV_W + 2 * QK_W + 2 * V_W + 4 * DN_HEADS

kernel_name = "hybrid_conv_gdn_diffusion_step"


def rmsnorm(x, w):
    xf = x.astype(jnp.float32)
    y = xf * lax.rsqrt(jnp.mean(xf * xf, axis=-1, keepdims=True) + EPS)
    return (y * w.astype(jnp.float32)).astype(x.dtype)


def l2norm(x):
    return x * lax.rsqrt(jnp.sum(x * x, axis=-1, keepdims=True) + EPS)


def row_conv3(u, w, row_len):
    b, l, ch = u.shape
    rows = l // row_len
    u4 = u.reshape(b, rows, row_len, ch)
    up = jnp.pad(u4, ((0, 0), (0, 0), (1, 1), (0, 0)))
    y = w[0] * up[:, :, :-2] + w[1] * up[:, :, 1:-1] + w[2] * up[:, :, 2:]
    return y.reshape(b, l, ch)


def grid_conv3x3(u, w, row_len):
    b, l, ch = u.shape
    rows = l // row_len
    u4 = u.reshape(b, rows, row_len, ch)
    y = lax.conv_general_dilated(u4, w[:, :, None, :], (1, 1), 'SAME',
                                 dimension_numbers=('NHWC', 'HWIO', 'NHWC'),
                                 feature_group_count=ch)
    return y.reshape(b, l, ch)


def chunked_gated_delta(q, k, v, beta, log_alpha, s0):
    b, l, h, dk = q.shape
    dv = v.shape[-1]
    n = l // CHUNK

    def blk(t):
        return jnp.moveaxis(t.reshape((b, n, CHUNK, h) + t.shape[3:]), 3, 1)

    q, k, v, beta = blk(q), blk(k), blk(v), blk(beta)
    g = jnp.cumsum(blk(log_alpha), axis=-1)
    idx = jnp.arange(CHUNK)
    strict = idx[:, None] > idx[None, :]
    incl = idx[:, None] >= idx[None, :]
    diff = g[..., :, None] - g[..., None, :]
    dec_strict = jnp.where(strict, jnp.exp(jnp.where(strict, diff, 0.0)), 0.0)
    dec_incl = jnp.where(incl, jnp.exp(jnp.where(incl, diff, 0.0)), 0.0)
    kb = k * beta[..., None]
    vb = v * beta[..., None]
    a_mat = jnp.eye(CHUNK, dtype=jnp.float32) + jnp.einsum('bhnid,bhnjd->bhnij', kb, k) * dec_strict
    u_val = lax.linalg.triangular_solve(a_mat, vb, left_side=True, lower=True, unit_diagonal=True)
    w_key = lax.linalg.triangular_solve(a_mat, kb * jnp.exp(g)[..., None], left_side=True,
                                        lower=True, unit_diagonal=True)
    qk = jnp.einsum('bhnid,bhnjd->bhnij', q, k) * dec_incl
    q_dec = q * jnp.exp(g)[..., None]
    g_last = g[..., -1:]
    k_end = k * jnp.exp(g_last - g)[..., None]
    chunk_decay = jnp.exp(g_last)[..., None]
    xs = tuple(jnp.moveaxis(t, 2, 0) for t in (u_val, w_key, qk, q_dec, k_end, chunk_decay))

    def step(s, inp):
        u_c, w_c, qk_c, qd_c, ke_c, dl_c = inp
        v_new = u_c - jnp.einsum('bhcd,bhde->bhce', w_c, s)
        o_c = jnp.einsum('bhcd,bhde->bhce', qd_c, s) + jnp.einsum('bhij,bhje->bhie', qk_c, v_new)
        s = s * dl_c + jnp.einsum('bhcd,bhce->bhde', ke_c, v_new)
        return s, o_c

    s_final, o = lax.scan(step, s0.astype(jnp.float32), xs)
    o = jnp.moveaxis(jnp.moveaxis(o, 0, 2), 1, 3).reshape(b, l, h, dv)
    return o, s_final


def mixer(h, row_len, s0_f, s0_b, w_in, conv_a_w, qkv_conv_w, a_log, dt_bias, o_norm_w, w_out):
    b, l, _ = h.shape
    z = h @ w_in
    cuts = [CONV_W, 2 * CONV_W, 3 * CONV_W, 3 * CONV_W + 2 * QK_W + V_W,
            3 * CONV_W + 2 * QK_W + 2 * V_W, 3 * CONV_W + 2 * QK_W + 2 * V_W + 2 * DN_HEADS]
    cb, cc, cx, qkv, gate, b_logit, a_in = jnp.split(z, cuts, axis=-1)
    y_conv = cb * row_conv3(cc * cx, conv_a_w, row_len)
    qkv = jax.nn.silu(row_conv3(qkv, qkv_conv_w, row_len)).astype(jnp.float32)
    q, k, v = jnp.split(qkv, [QK_W, 2 * QK_W], axis=-1)
    q = l2norm(q.reshape(b, l, DN_HEADS, DK)) * (DK ** -0.5)
    k = l2norm(k.reshape(b, l, DN_HEADS, DK))
    v = v.reshape(b, l, DN_HEADS, DV)
    beta = jax.nn.sigmoid(b_logit.astype(jnp.float32)).reshape(b, l, 2, DN_HEADS)
    log_alpha = -jnp.exp(a_log.astype(jnp.float32)) * jax.nn.softplus(
        a_in.astype(jnp.float32).reshape(b, l, 2, DN_HEADS) + dt_bias.astype(jnp.float32))
    o_f, s_f = chunked_gated_delta(q, k, v, beta[:, :, 0], log_alpha[:, :, 0], s0_f)
    rev = lambda t: t[:, ::-1]
    o_b, s_b = chunked_gated_delta(rev(q), rev(k), rev(v), rev(beta[:, :, 1]),
                                   rev(log_alpha[:, :, 1]), s0_b)
    o = o_f + rev(o_b)
    o = rmsnorm(o, o_norm_w) * jax.nn.silu(gate.astype(jnp.float32).reshape(b, l, DN_HEADS, DV))
    y = jnp.concatenate([y_conv, o.reshape(b, l, V_W).astype(h.dtype)], axis=-1) @ w_out
    return y, s_f, s_b


def conv_glu(h, row_len, w_up, ffn_conv_w, w_down):
    u, gt = jnp.split(h @ w_up, 2, axis=-1)
    gt = grid_conv3x3(gt, ffn_conv_w, row_len)
    return (jax.nn.gelu(gt) * u) @ w_down


def block(x, mod, row_len, s0_f, s0_b, norm1_w, w_in, conv_a_w, qkv_conv_w, a_log, dt_bias,
          o_norm_w, w_out, norm2_w, w_up, ffn_conv_w, w_down):
    shift1, scale1, gate1, shift2, scale2, gate2 = jnp.split(mod, 6, axis=-1)
    h = rmsnorm(x, norm1_w) * (1 + scale1) + shift1
    y, s_f, s_b = mixer(h, row_len, s0_f, s0_b, w_in, conv_a_w, qkv_conv_w, a_log, dt_bias,
                        o_norm_w, w_out)
    x = x + gate1 * y
    h = rmsnorm(x, norm2_w) * (1 + scale2) + shift2
    x = x + gate2 * conv_glu(h, row_len, w_up, ffn_conv_w, w_down)
    return x, s_f, s_b


def setup_inputs(seed: int = 0) -> dict:
    key = jax.random.key(seed)
    ks = jax.random.split(key, 24)
    nrm = lambda k, shape, s: jax.random.normal(k, shape, jnp.float32) * s
    dt = jnp.exp(jax.random.uniform(ks[10], (DEPTH, 2, DN_HEADS), jnp.float32,
                                    np.log(1e-3), np.log(1e-1)))
    return {
        "x_prompt": nrm(ks[0], (BATCH, SEQ, D_MODEL), 1.0),
        "x_sample": nrm(ks[1], (DEC_BATCH, DEC_SEQ, D_MODEL), 1.0),
        "state_deltanet": nrm(ks[2], (DEC_BATCH, DEPTH, 2, DN_HEADS, DK, DV), 0.3),
        "c": nrm(ks[3], (DEC_BATCH, D_MODEL), 1.0),
        "c_ctx": nrm(ks[4], (D_MODEL,), 1.0),
        "w_ada": nrm(ks[5], (DEPTH, D_MODEL, 6 * D_MODEL), 0.5 * D_MODEL ** -0.5),
        "b_ada": nrm(ks[6], (DEPTH, 6 * D_MODEL), 0.02),
        "norm1_w": 1.0 + nrm(ks[7], (DEPTH, D_MODEL), 0.02),
        "w_in": nrm(ks[8], (DEPTH, D_MODEL, IN_COLS), D_MODEL ** -0.5),
        "conv_a_w": nrm(ks[9], (DEPTH, 3, CONV_W), 0.5),
        "qkv_conv_w": nrm(ks[11], (DEPTH, 3, 2 * QK_W + V_W), 0.5),
        "a_log": jnp.log(jax.random.uniform(ks[12], (DEPTH, 2, DN_HEADS), jnp.float32, 1.0, 16.0)),
        "dt_bias": dt + jnp.log(-jnp.expm1(-dt)),
        "o_norm_w": 1.0 + nrm(ks[13], (DEPTH, DV), 0.02),
        "w_out": nrm(ks[14], (DEPTH, D_MIX, D_MODEL), D_MIX ** -0.5),
        "norm2_w": 1.0 + nrm(ks[15], (DEPTH, D_MODEL), 0.02),
        "w_up": nrm(ks[16], (DEPTH, D_MODEL, 2 * D_FF), D_MODEL ** -0.5),
        "ffn_conv_w": nrm(ks[17], (DEPTH, 3, 3, D_FF), 1.0 / 3.0),
        "w_down": nrm(ks[18], (DEPTH, D_FF, D_MODEL), D_FF ** -0.5),
        "final_norm_w": 1.0 + nrm(ks[19], (D_MODEL,), 0.02),
    }


def reference(x_prompt, x_sample, state_deltanet, c, c_ctx, w_ada, b_ada, norm1_w, w_in,
              conv_a_w, qkv_conv_w, a_log, dt_bias, o_norm_w, w_out, norm2_w, w_up,
              ffn_conv_w, w_down, final_norm_w):
    b_ctx, ctx_len, _ = x_prompt.shape
    xp = x_prompt
    xs = x_sample
    zero_state = jnp.zeros((b_ctx, DN_HEADS, DK, DV), jnp.float32)
    ctx_states = []
    for l in range(DEPTH):
        layer_w = (norm1_w[l], w_in[l], conv_a_w[l], qkv_conv_w[l], a_log[l], dt_bias[l],
                   o_norm_w[l], w_out[l], norm2_w[l], w_up[l], ffn_conv_w[l], w_down[l])
        mod_ctx = jax.nn.silu(c_ctx) @ w_ada[l] + b_ada[l]
        xp, s_f, s_b = block(xp, mod_ctx, ctx_len, zero_state, zero_state, *layer_w)
        ctx_states.append(jnp.stack([s_f, s_b], axis=1))
        mod_lat = (jax.nn.silu(c) @ w_ada[l] + b_ada[l])[:, None, :]
        xs, _, _ = block(xs, mod_lat, GRID_W, state_deltanet[:, l, 0], state_deltanet[:, l, 1],
                         *layer_w)
    y_prompt = rmsnorm(xp, final_norm_w)
    y_sample = rmsnorm(xs, final_norm_w)
    new_state_deltanet = jnp.stack(ctx_states, axis=1)
    return (y_prompt, y_sample, new_state_deltanet)
```

```cpp
#include <hip/hip_runtime.h>
#include <hip/hip_cooperative_groups.h>
#include <cstdio>
#include <cstdint>
namespace cg = cooperative_groups;
namespace pg8 {
#define PG8_LAS __attribute__((address_space(3)))
typedef unsigned short bf16_t;
typedef short bf16x8 __attribute__((ext_vector_type(8)));
typedef float f32x4 __attribute__((ext_vector_type(4)));
typedef unsigned u32x4 __attribute__((ext_vector_type(4)));
constexpr int BM = 256, BK = 64, HALF = 128, HTB = HALF * BK * 2  , STAGE_BYTES = 8 * HTB, NXCD = 8, WGM = 8;

__host__ __device__ __forceinline__ int lds_byte(int r, int c) { const int st = (r >> 4) * 2 + (c >> 5), rr = r & 15, cc = c & 31, ob = rr * 64 + cc * 2; return st * 1024 + (ob ^ (((ob >> 9) & 1) << 5)); }
__host__ __device__ __forceinline__ void stage_rc(int b, int& R, int& C) { const int st = b / 1024, sb = b % 1024, swz = sb ^ (((sb >> 9) & 1) << 5); R = (st >> 1) * 16 + swz / 64; C = (st & 1) * 32 + (swz % 64) / 2; }
__host__ __device__ __forceinline__ int perm32(int rho) { const int n = rho >> 4, i = rho & 15; return 8 * (i >> 2) + 4 * n + (i & 3); }

struct Unit { int pm, pn; };
struct Gemm { const bf16_t* A; const bf16_t* Bt; int M, N, K; };

struct StaticOrder {
    int nM, nN, nwg, G, c;
    __host__ __device__ void init(int M, int N, int G_, int c_) { nM = M / BM; nN = N / BM; nwg = nM * nN; G = G_; c = c_; }
    __host__ __device__ bool next(int i, Unit& u) const {
        const long L = (long)i * G + c; if (L >= nwg) return false;
        int wgid = (int)L; { const int q = nwg / NXCD, r = nwg % NXCD, xcd = wgid % NXCD, off = wgid / NXCD; wgid = (xcd < r ? xcd * (q + 1) : r * (q + 1) + (xcd - r) * q) + off; }
        const int nig = WGM * nN, gid = wgid / nig, fm = gid * WGM, gsz = (nM - fm) < WGM ? (nM - fm) : WGM;
        u.pm = fm + ((wgid % nig) % gsz); u.pn = (wgid % nig) / gsz; return true;
    }
    __device__ __forceinline__ void a_ready(const Unit&) const {}
    __device__ __forceinline__ void done(const Unit&) const {}
};
struct FlexOrder {
    int nM, nN, nwg, G, c, nb, qb;
    __host__ __device__ void init(int M, int N, int G_, int c_, int nb_, int qb_) { nM = M / BM; nN = N / BM; nwg = nM * nN; G = G_; c = c_; nb = nb_; qb = qb_; }
    __host__ __device__ bool next(int i, Unit& u) const {
        long L;
        if (c < nb) { if (i >= qb) return false; L = (long)c + (long)nb * i; } else L = (long)nb * qb + (c - nb) + (long)(G - nb) * i;
        if (L >= nwg) return false;
        int wgid = (int)L; { const int q = nwg / NXCD, r = nwg % NXCD, xcd = wgid % NXCD, off = wgid / NXCD; wgid = (xcd < r ? xcd * (q + 1) : r * (q + 1) + (xcd - r) * q) + off; }
        const int nig = WGM * nN, gid = wgid / nig, fm = gid * WGM, gsz = (nM - fm) < WGM ? (nM - fm) : WGM;
        u.pm = fm + ((wgid % nig) % gsz); u.pn = (wgid % nig) / gsz; return true;
    }
    __device__ __forceinline__ void a_ready(const Unit&) const {}
    __device__ __forceinline__ void done(const Unit&) const {}
};

typedef __bf16 bf16v2_t __attribute__((ext_vector_type(2))); typedef float f32v2_t __attribute__((ext_vector_type(2)));
__device__ __forceinline__ unsigned cvt_pk_bf16(float lo, float hi) { const f32v2_t v = {lo, hi}; const bf16v2_t b = __builtin_convertvector(v, bf16v2_t); return __builtin_bit_cast(unsigned, b); }
typedef unsigned u32x4 __attribute__((ext_vector_type(4)));
struct EpiIn {
    static constexpr bool PERM = true, AFTER_DRAIN = false;
    bf16_t *CB, *P, *ZQ, *ZG; float* BA;
    __device__ __forceinline__ void operator()(const f32x4 (&acc)[2][2][4][2], const Unit& u, int wr, int wc, int fr, int fq) const {
        const int row0 = u.pm * BM + wr * 64 + fr; const int pn = u.pn; const int cl = wc * 32 + 8 * fq;
        if (pn == 14) {
            if (wc == 0 && fq < 2) {
#pragma unroll
                for (int ai = 0; ai < 2; ++ai)
#pragma unroll
                    for (int m = 0; m < 4; ++m) { float* rp = BA + (size_t)(row0 + ai * HALF + m * 16) * 16 + 8 * fq;
                        *(f32x4*)rp = acc[ai][0][m][0]; *(f32x4*)(rp + 4) = acc[ai][0][m][1]; } }
        } else if (pn >= 2 && pn < 6) {
#pragma unroll
            for (int ai = 0; ai < 2; ++ai)
#pragma unroll
                for (int m = 0; m < 4; ++m) { bf16_t* rowp = P + (size_t)(row0 + ai * HALF + m * 16) * 512 + (pn - 2) * 128 + cl;
                    const f32x4 v0 = acc[ai][0][m][0] * acc[ai][1][m][0], v1 = acc[ai][0][m][1] * acc[ai][1][m][1];
                    u32x4 w; w.x = cvt_pk_bf16(v0[0], v0[1]); w.y = cvt_pk_bf16(v0[2], v0[3]); w.z = cvt_pk_bf16(v1[0], v1[1]); w.w = cvt_pk_bf16(v1[2], v1[3]);
                    *(u32x4*)rowp = w; }
        } else {
            bf16_t* base; int ldc, c0;
            if (pn < 2) { base = CB; ldc = 512; c0 = pn * 256; } else if (pn < 12) { base = ZQ; ldc = 1536; c0 = (pn - 6) * 256; } else { base = ZG; ldc = 512; c0 = (pn - 12) * 256; }
#pragma unroll
            for (int ai = 0; ai < 2; ++ai)
#pragma unroll
                for (int m = 0; m < 4; ++m) { bf16_t* rowp = base + (size_t)(row0 + ai * HALF + m * 16) * ldc + c0 + cl;
#pragma unroll
                    for (int bj = 0; bj < 2; ++bj) { const f32x4 v0 = acc[ai][bj][m][0], v1 = acc[ai][bj][m][1];
                        u32x4 w; w.x = cvt_pk_bf16(v0[0], v0[1]); w.y = cvt_pk_bf16(v0[2], v0[3]); w.z = cvt_pk_bf16(v1[0], v1[1]); w.w = cvt_pk_bf16(v1[2], v1[3]);
                        *(u32x4*)(rowp + bj * HALF) = w; } }
        }
    }
};
struct EpiUp {
    static constexpr bool PERM = true, AFTER_DRAIN = false;
    bf16_t* O; int ldc;
    __device__ __forceinline__ void operator()(const f32x4 (&acc)[2][2][4][2], const Unit& u, int wr, int wc, int fr, int fq) const {
        const int row0 = u.pm * BM + wr * 64 + fr; const int col0 = u.pn * BM + wc * 32 + 8 * fq;
#pragma unroll
        for (int ai = 0; ai < 2; ++ai)
#pragma unroll
            for (int m = 0; m < 4; ++m) { bf16_t* rowp = O + (size_t)(row0 + ai * HALF + m * 16) * ldc + col0;
#pragma unroll
                for (int bj = 0; bj < 2; ++bj) { const f32x4 v0 = acc[ai][bj][m][0], v1 = acc[ai][bj][m][1];
                    u32x4 w; w.x = cvt_pk_bf16(v0[0], v0[1]); w.y = cvt_pk_bf16(v0[2], v0[3]); w.z = cvt_pk_bf16(v1[0], v1[1]); w.w = cvt_pk_bf16(v1[2], v1[3]);
                    *(u32x4*)(rowp + bj * HALF) = w; } }
    }
};
struct EpiRes {
    static constexpr bool PERM = false, AFTER_DRAIN = false;
    const float* base_ctx; const float* base_lat; float* out; const float* gate; int row_base;
    __device__ __forceinline__ void operator()(const f32x4 (&acc)[2][2][4][2], const Unit& u, int wr, int wc, int fr, int fq) const {
        const int grow0 = row_base + u.pm * BM;
        const int mi = grow0 < 4096 ? 0 : 1 + ((grow0 - 4096) >> 11);
        const float* g = gate + (size_t)mi * 6144;
        const float* bsrc = grow0 < 4096 ? base_ctx + (size_t)grow0 * 1024 : base_lat + (size_t)(grow0 - 4096) * 1024;
        float* o = out + (size_t)grow0 * 1024;
        const int col0 = u.pn * BM + wc * 32 + 4 * fq;
#pragma unroll
        for (int bj = 0; bj < 2; ++bj)
#pragma unroll
            for (int n = 0; n < 2; ++n) { const f32x4 gv = *(const f32x4*)(g + col0 + bj * HALF + n * 16);
#pragma unroll
                for (int ai = 0; ai < 2; ++ai) {
#pragma unroll
                    for (int m = 0; m < 4; ++m) { const size_t off = (size_t)(ai * HALF + wr * 64 + m * 16 + fr) * 1024 + col0 + bj * HALF + n * 16;
                        const f32x4 bs = *(const f32x4*)(bsrc + off); *(f32x4*)(o + off) = bs + gv * acc[ai][bj][m][n]; }
                    asm volatile("" ::: "memory"); } }
    }
};
template <class Epi, class Sched, bool ALIGN_EPI = false, bool SP2 = false>
__device__ __forceinline__ void gemm_phase(PG8_LAS unsigned char* lds, const Gemm g, const Sched& S, const Epi& E, const int tid_in) {
    const int tid = tid_in, wid = __builtin_amdgcn_readfirstlane(tid >> 6), lane = tid & 63, wr = wid >> 2, wc = wid & 3, fr = lane & 15, fq = lane >> 4;
    const int K = g.K, nt = K / BK;
    unsigned voffA[2], voffB[2];
#pragma unroll
    for (int i = 0; i < 2; ++i) { int R, C; stage_rc(tid * 16 + i * 8192, R, C); const int Rb = Epi::PERM ? ((R & ~31) + perm32(R & 31)) : R;
        voffA[i] = (unsigned)(R * K + C) * 2u; voffB[i] = (unsigned)(Rb * K + C) * 2u; }
    const size_t kstep = (size_t)(BK * 2);
    const size_t hstep = (size_t)HALF * K * 2;
    const size_t tstep = 2 * hstep;
    const unsigned ldsw = (unsigned)wid * 1024u;
    const int aoff = lds_byte(wr * 64 + fr, fq * 8), boff = lds_byte(wc * 32 + fr, fq * 8);
#define PG8_SA(b, h) (((b) * 2 + (h)) * HTB)
#define PG8_SB(b, h) ((4 + (b) * 2 + (h)) * HTB)
#define PG8_STAGE(bufoff, gbase, voff) do { _Pragma("unroll") for (int _i = 0; _i < 2; ++_i) \
        __builtin_amdgcn_global_load_lds((const unsigned*)((const char*)(gbase) + (voff)[_i]), (PG8_LAS unsigned*)(lds + (bufoff) + ldsw + _i * 8192), 16, 0, 0); } while (0)
#define PG8_LDA(dst, b, h) do { _Pragma("unroll") for (int m = 0; m < 4; ++m) _Pragma("unroll") for (int k = 0; k < 2; ++k) dst[m][k] = *(const PG8_LAS bf16x8*)(lds + PG8_SA(b, h) + aoff + m * 2048 + k * 1024); } while (0)
#define PG8_LDB(dst, b, h) do { _Pragma("unroll") for (int n = 0; n < 2; ++n) _Pragma("unroll") for (int k = 0; k < 2; ++k) dst[n][k] = *(const PG8_LAS bf16x8*)(lds + PG8_SB(b, h) + boff + n * 2048 + k * 1024); } while (0)
#define PG8_MMA(ai, bj, At, Bt) do { __builtin_amdgcn_s_setprio(1); _Pragma("unroll") for (int m = 0; m < 4; ++m) _Pragma("unroll") for (int n = 0; n < 2; ++n) _Pragma("unroll") for (int k = 0; k < 2; ++k) \
        acc[ai][bj][m][n] = __builtin_amdgcn_mfma_f32_16x16x32_bf16(Bt[n][k], At[m][k], acc[ai][bj][m][n], 0, 0, 0); __builtin_amdgcn_s_setprio(0); } while (0)
#define PG8_WAIT_V(n) asm volatile("s_waitcnt vmcnt(" #n ")" ::: "memory")
#define PG8_WAIT_L(n) asm volatile("s_waitcnt lgkmcnt(" #n ")" ::: "memory")
#define PG8_BAR __builtin_amdgcn_s_barrier()
#define PG8_SCHED __builtin_amdgcn_sched_barrier(0)
    Unit cur, nxt; int ui = 0;
    if (!S.next(0, cur)) return;
    f32x4 acc[2][2][4][2];
#pragma unroll
    for (int a = 0; a < 2; ++a)
#pragma unroll
        for (int b = 0; b < 2; ++b)
#pragma unroll
            for (int m = 0; m < 4; ++m)
#pragma unroll
                for (int n = 0; n < 2; ++n) acc[a][b][m][n] = (f32x4){0.f, 0.f, 0.f, 0.f};
    bf16x8 At[4][2], B0[2][2], B1[2][2];
    const char* cA = (const char*)g.A + (size_t)cur.pm * tstep; const char* cB = (const char*)g.Bt + (size_t)cur.pn * tstep;
    S.a_ready(cur);
    if constexpr (SP2) {
        PG8_STAGE(PG8_SB(0, 0), cB, voffB); PG8_STAGE(PG8_SB(0, 1), cB + hstep, voffB); PG8_STAGE(PG8_SA(0, 0), cA, voffA); PG8_STAGE(PG8_SA(0, 1), cA + hstep, voffA);
        if (wr == 1) PG8_BAR;
        PG8_WAIT_V(2); PG8_BAR;
        PG8_STAGE(PG8_SB(1, 0), cB + kstep, voffB); PG8_STAGE(PG8_SA(1, 0), cA + kstep, voffA); PG8_STAGE(PG8_SB(1, 1), cB + hstep + kstep, voffB);
        PG8_WAIT_V(6); PG8_BAR;
    } else {
        PG8_STAGE(PG8_SB(0, 0), cB, voffB); PG8_STAGE(PG8_SA(0, 0), cA, voffA); PG8_STAGE(PG8_SB(0, 1), cB + hstep, voffB); PG8_STAGE(PG8_SA(0, 1), cA + hstep, voffA);
        if (wr == 1) PG8_BAR;
        PG8_WAIT_V(4); PG8_BAR;
        PG8_STAGE(PG8_SB(1, 0), cB + kstep, voffB); PG8_STAGE(PG8_SA(1, 0), cA + kstep, voffA); PG8_STAGE(PG8_SB(1, 1), cB + hstep + kstep, voffB);
        PG8_WAIT_V(6); PG8_BAR;
    }
    for (;;) {
        const bool has_next = S.next(ui + 1, nxt);
        const char* nA = has_next ? (const char*)g.A + (size_t)nxt.pm * tstep : cA; const char* nB = has_next ? (const char*)g.Bt + (size_t)nxt.pn * tstep : cB;
        for (int t = 0; t < nt; t += 2) {
            const bool last = (t == nt - 2);
            const char* a1 = cA + (size_t)(t + 1) * kstep;
            const char* a2 = last ? nA : cA + (size_t)(t + 2) * kstep; const char* b2 = last ? nB : cB + (size_t)(t + 2) * kstep;
            const char* a3 = a2 + kstep; const char* b3 = b2 + kstep;
            if (last && has_next) S.a_ready(nxt);
            if constexpr (SP2) {
            PG8_LDB(B0, 0, 0); PG8_LDB(B1, 0, 1); PG8_SCHED; PG8_LDA(At, 0, 0); PG8_STAGE(PG8_SA(1, 1), a1 + hstep, voffA);
            PG8_WAIT_V(8); PG8_WAIT_L(0); PG8_BAR; PG8_MMA(0, 0, At, B0); PG8_MMA(0, 1, At, B1); PG8_BAR; PG8_SCHED;
            PG8_LDA(At, 0, 1); PG8_STAGE(PG8_SB(0, 0), b2, voffB); PG8_STAGE(PG8_SB(0, 1), b2 + hstep, voffB); PG8_STAGE(PG8_SA(0, 0), a2, voffA);
            PG8_WAIT_V(8); PG8_WAIT_L(0); PG8_BAR; PG8_MMA(1, 0, At, B0); PG8_MMA(1, 1, At, B1); PG8_BAR; PG8_SCHED;
            PG8_LDB(B0, 1, 0); PG8_LDB(B1, 1, 1); PG8_SCHED; PG8_LDA(At, 1, 0); PG8_STAGE(PG8_SA(0, 1), a2 + hstep, voffA);
            PG8_WAIT_V(8); PG8_WAIT_L(0); PG8_BAR; PG8_MMA(0, 0, At, B0); PG8_MMA(0, 1, At, B1); PG8_BAR; PG8_SCHED;
            PG8_LDA(At, 1, 1); PG8_STAGE(PG8_SB(1, 0), b3, voffB); PG8_STAGE(PG8_SB(1, 1), b3 + hstep, voffB); PG8_STAGE(PG8_SA(1, 0), a3, voffA);
            PG8_WAIT_V(8); PG8_WAIT_L(0); PG8_BAR; PG8_MMA(1, 0, At, B0); PG8_MMA(1, 1, At, B1); PG8_BAR; PG8_SCHED;
            } else {
            PG8_LDB(B0, 0, 0); PG8_SCHED; PG8_LDA(At, 0, 0); PG8_STAGE(PG8_SA(1, 1), a1 + hstep, voffA);
            PG8_WAIT_L(8); PG8_BAR; PG8_WAIT_L(0); PG8_MMA(0, 0, At, B0); PG8_BAR; PG8_SCHED;
            PG8_LDB(B1, 0, 1); PG8_STAGE(PG8_SB(0, 0), b2, voffB);
            PG8_BAR; PG8_WAIT_L(0); PG8_MMA(0, 1, At, B1); PG8_BAR;
            PG8_LDA(At, 0, 1); PG8_STAGE(PG8_SA(0, 0), a2, voffA);
            PG8_BAR; PG8_WAIT_L(0); PG8_MMA(1, 0, At, B0); PG8_BAR; PG8_SCHED;
            PG8_STAGE(PG8_SB(0, 1), b2 + hstep, voffB);
            PG8_WAIT_V(6); PG8_BAR; PG8_MMA(1, 1, At, B1); PG8_BAR;
            PG8_LDB(B0, 1, 0); PG8_SCHED; PG8_LDA(At, 1, 0); PG8_STAGE(PG8_SA(0, 1), a2 + hstep, voffA);
            PG8_WAIT_L(8); PG8_BAR; PG8_WAIT_L(0); PG8_MMA(0, 0, At, B0); PG8_BAR; PG8_SCHED;
            PG8_LDB(B1, 1, 1); PG8_STAGE(PG8_SB(1, 0), b3, voffB);
            PG8_BAR; PG8_WAIT_L(0); PG8_MMA(0, 1, At, B1); PG8_BAR;
            PG8_LDA(At, 1, 1); PG8_STAGE(PG8_SA(1, 0), a3, voffA);
            PG8_BAR; PG8_WAIT_L(0); PG8_MMA(1, 0, At, B0); PG8_BAR; PG8_SCHED;
            PG8_STAGE(PG8_SB(1, 1), b3 + hstep, voffB);
            PG8_WAIT_V(6); PG8_BAR; PG8_MMA(1, 1, At, B1); PG8_BAR;
            }
        }
        if constexpr (ALIGN_EPI) { if (wr == 0) PG8_BAR; }
        if constexpr (!Epi::AFTER_DRAIN) { E(acc, cur, wr, wc, fr, fq); S.done(cur); }
        if (!has_next) break;
#pragma unroll
        for (int a = 0; a < 2; ++a)
#pragma unroll
            for (int b = 0; b < 2; ++b)
#pragma unroll
                for (int m = 0; m < 4; ++m)
#pragma unroll
                    for (int n = 0; n < 2; ++n) acc[a][b][m][n] = (f32x4){0.f, 0.f, 0.f, 0.f};
        cur = nxt; cA = nA; cB = nB; ++ui;
        if constexpr (ALIGN_EPI) { if (wr == 1) PG8_BAR; }
    }
    PG8_WAIT_V(0);
    if constexpr (!ALIGN_EPI) { if (wr == 0) PG8_BAR; }
    PG8_BAR;
    if constexpr (Epi::AFTER_DRAIN) { E.fused(acc, cur, wr, wc, fr, fq, lds, wid, lane); S.done(cur); }
#undef PG8_SA
#undef PG8_SB
#undef PG8_STAGE
#undef PG8_LDA
#undef PG8_LDB
#undef PG8_MMA
#undef PG8_WAIT_V
#undef PG8_WAIT_L
#undef PG8_BAR
#undef PG8_SCHED
}
}

#define LAS __attribute__((address_space(3)))
using pg8::bf16_t; using pg8::bf16x8; using pg8::f32x4; using pg8::u32x4;
typedef float f32x16 __attribute__((ext_vector_type(16)));
typedef unsigned u32x2 __attribute__((ext_vector_type(2)));

#define REP_PRE 1
#define REP_SCAN 1
#define REP_ACT 1
#define REP_SYNC 0
#define REP_EW 1
#define REP_GIN 1
#define REP_INV 1
#define REP_BLD 1
#define REP_PH1 1
#define REP_CV 1
#define REP_MX 1
#define REP_PH2 1
#ifndef PHMASK
#define PHMASK 0xFFFF
#endif
constexpr int MTOK = 20480;
constexpr float EPS = 1e-6f;
constexpr size_t MiB = (size_t)1 << 20;
constexpr int LDS_BYTES = 147456;
constexpr size_t WS_MOD = 0;
constexpr size_t WS_BAR = 448 * 1024;
constexpr size_t WS_WINX = 512 * 1024;
constexpr size_t WS_WIN = 1 * MiB;
constexpr size_t WS_WOUT = 8 * MiB + 512 * 1024;
constexpr size_t WS_WUP = 10 * MiB + 512 * 1024;
constexpr size_t WS_WDN = 21 * MiB + 512 * 1024;
constexpr size_t WS_BA = 27 * MiB;
constexpr size_t WS_GC = 28 * MiB + 512 * 1024;
constexpr size_t WS_BT = 29 * MiB + 256 * 1024;
constexpr size_t WS_S = 30 * MiB;
constexpr size_t WS_H = WS_S;
constexpr size_t WS_ZG = WS_S + 40 * MiB;
constexpr size_t WS_QKVN = WS_S + 60 * MiB;
constexpr size_t WS_CB = WS_S + 120 * MiB;
constexpr size_t WS_P = WS_S + 140 * MiB;
constexpr size_t WS_ZQ = WS_S + 160 * MiB;
constexpr size_t WS_TQK = WS_ZQ;
constexpr size_t WS_OF = WS_ZQ + 40 * MiB;
constexpr size_t WS_OB = WS_CB;
constexpr size_t WS_UP = WS_S + 40 * MiB;
constexpr size_t WS_ACT = WS_S + 150 * MiB;

struct Args {
    const float *x_prompt, *x_sample, *state, *c, *c_ctx, *w_ada, *b_ada, *norm1_w, *w_in, *conv_a_w, *qkv_conv_w, *a_log, *dt_bias, *o_norm_w, *w_out, *norm2_w, *w_up,
        *ffn_conv_w, *w_down, *final_norm_w;
    float* out; unsigned char* ws;
};
__device__ __forceinline__ unsigned opq_lane() { unsigned z = 0u; asm volatile("" : "+v"(z)); return __builtin_amdgcn_mbcnt_hi(~0u, __builtin_amdgcn_mbcnt_lo(~0u, z)); }
#define CAS __attribute__((address_space(4)))
#define GAS __attribute__((address_space(1)))
__device__ __forceinline__ Args load_args() {
    Args r{};
#if defined(__HIP_DEVICE_COMPILE__)
    const CAS unsigned long long* ap = (const CAS unsigned long long*)__builtin_amdgcn_kernarg_segment_ptr(); asm volatile("" : "+s"(ap));
    const float** rp = (const float**)&r;
#pragma unroll
    for (int i = 0; i < 20; ++i) rp[i] = (const float*)(const GAS float*)ap[i];
    r.out = (float*)(GAS float*)ap[20]; r.ws = (unsigned char*)(GAS unsigned char*)ap[21];
#endif
    return r;
}

__device__ __forceinline__ float bflo(unsigned w) { return __builtin_bit_cast(float, w << 16); }
__device__ __forceinline__ float bfhi(unsigned w) { return __builtin_bit_cast(float, w & 0xffff0000u); }
__device__ __forceinline__ float bf2f(bf16_t b) { return __builtin_bit_cast(float, (unsigned)b << 16); }
__device__ __forceinline__ unsigned pk(float lo, float hi) { return pg8::cvt_pk_bf16(lo, hi); }
__device__ __forceinline__ bf16_t f2bf(float f) { return (bf16_t)(pk(f, 0.f) & 0xffffu); }
__device__ __forceinline__ float shx(const float v, const int o, const int lane) { return __builtin_bit_cast(float, __builtin_amdgcn_ds_bpermute((lane ^ o) << 2, __builtin_bit_cast(int, v))); }
__device__ __forceinline__ float wave_sum(float v) {
#pragma unroll
    for (int o = 1; o < 64; o <<= 1) v += __shfl_xor(v, o);
    return v;
}
__device__ __forceinline__ float silu_f(float x) { return x / (1.f + __expf(-x)); }
__device__ __forceinline__ void unpack8(const u32x4 w, float (&f)[8]) {
    f[0] = bflo(w.x); f[1] = bfhi(w.x); f[2] = bflo(w.y); f[3] = bfhi(w.y); f[4] = bflo(w.z); f[5] = bfhi(w.z); f[6] = bflo(w.w); f[7] = bfhi(w.w);
}
__device__ __forceinline__ u32x4 pack8(const float (&f)[8]) { u32x4 w; w.x = pk(f[0], f[1]); w.y = pk(f[2], f[3]); w.z = pk(f[4], f[5]); w.w = pk(f[6], f[7]); return w; }
__device__ __forceinline__ void load8f(const float* p, float (&f)[8]) { const f32x4 a = *(const f32x4*)p, b = *(const f32x4*)(p + 4); f[0] = a.x; f[1] = a.y; f[2] = a.z; f[3] = a.w; f[4] = b.x; f[5] = b.y; f[6] = b.z; f[7] = b.w; }
__device__ __forceinline__ int opq_tid(const int wv) { int t = wv * 64 + (int)opq_lane(); asm volatile("" : "+v"(t)); return t; }
__device__ __forceinline__ int opq_bid() { int b = blockIdx.x; asm volatile("" : "+s"(b)); return b; }
#define MFMA32(a, b, c) __builtin_amdgcn_mfma_f32_32x32x16_bf16((a), (b), (c), 0, 0, 0)
#define LDS_WAIT() asm volatile("s_waitcnt lgkmcnt(0)" ::: "memory")

#define XB_TMO      128
#define XB_XCNT(j)  (256  + 64 * (j))
#define XB_XSUB(j)  (1280 + 64 * (j))
#define XB_XGEN(j)  (2304 + 64 * (j))
#define XB_TOP      3328
#define XB_TOPGEN   3392
#define XCD_BAR_WORDS 3456
#define XB_SPIN_CAP (1u << 18)

__device__ __forceinline__ unsigned xb_ld(unsigned* p)              { return __hip_atomic_load(p, __ATOMIC_RELAXED, __HIP_MEMORY_SCOPE_AGENT); }
__device__ __forceinline__ unsigned xb_add(unsigned* p, unsigned v) { return __hip_atomic_fetch_add(p, v, __ATOMIC_RELAXED, __HIP_MEMORY_SCOPE_AGENT); }
__device__ __forceinline__ unsigned xb_xcc_id() { return (unsigned)__builtin_amdgcn_s_getreg((3 << 11) | 20) & 0xFu; }
#define XB_SPIN(cond, bar) do { unsigned _sp = 0; while (cond) { __builtin_amdgcn_s_sleep(1); \
    if ((++_sp & 255u) == 0u) { if (xb_ld(&(bar)[XB_TMO])) break; if (_sp > XB_SPIN_CAP) { atomicAdd(&(bar)[XB_TMO], 1u); break; } } } } while (0)

struct XcdBarrier {
    int wv; unsigned* bar; unsigned x;
    volatile LAS unsigned* st;
};

__device__ __forceinline__ XcdBarrier xcd_barrier_post(unsigned* bar, volatile LAS unsigned* st, const int wv0) {
    XcdBarrier b; b.bar = bar; b.x = xb_xcc_id(); b.st = st; b.wv = wv0;
    if (wv0 == 0 && opq_lane() == 0u) (void)xb_add(&bar[XB_XCNT(b.x)], 1u);
    return b;
}
__device__ __forceinline__ void xcd_barrier_complete(unsigned* bar, unsigned x, unsigned& nloc, unsigned& nx) {
    const unsigned G = gridDim.x * gridDim.y * gridDim.z;
    unsigned sum, cnt, mine, sp = 0u;
    for (;;) {
        sum = 0u; cnt = 0u; mine = 0u;
#pragma unroll
        for (unsigned j = 0; j < 16; ++j) { const unsigned c = xb_ld(&bar[XB_XCNT(j)]); sum += c; cnt += (c > 0u) ? 1u : 0u; mine = (j == x) ? c : mine; }
        if (sum == G) break;
        __builtin_amdgcn_s_sleep(1);
        if ((++sp & 255u) == 0u) { if (xb_ld(&bar[XB_TMO])) break; if (sp > XB_SPIN_CAP) { atomicAdd(&bar[XB_TMO], 1u); break; } }
    }
    nloc = mine > 0u ? mine : 1u; nx = cnt > 0u ? cnt : 1u;
}

__device__ __forceinline__ void xcd_barrier(const XcdBarrier& b) {
    asm volatile("s_waitcnt vmcnt(0)" ::: "memory");
    __syncthreads();
    if (b.wv == 0 && opq_lane() == 0u) {
        unsigned* bar = b.bar;
        __builtin_amdgcn_s_waitcnt(0);
        unsigned nloc = b.st[0], nx = b.st[1];
        if (nloc == 0u) { xcd_barrier_complete(bar, b.x, nloc, nx); b.st[0] = nloc; b.st[1] = nx; }
        const unsigned old = xb_add(&bar[XB_XSUB(b.x)], 1u);
        const unsigned gen = old / nloc;
        if (old + 1u == (gen + 1u) * nloc) {
            __builtin_amdgcn_fence(__ATOMIC_RELEASE, "agent");
            asm volatile("s_waitcnt vmcnt(0)" ::: "memory");
            const unsigned og = xb_add(&bar[XB_TOP], 1u);
            const unsigned tg = og / nx;
            if (og + 1u == (tg + 1u) * nx) xb_add(&bar[XB_TOPGEN], 1u);
            else XB_SPIN(xb_ld(&bar[XB_TOPGEN]) == tg, bar);
            __builtin_amdgcn_fence(__ATOMIC_ACQUIRE, "agent");
            xb_add(&bar[XB_XGEN(b.x)], 1u);
            asm volatile("s_waitcnt vmcnt(0)" ::: "memory");
        } else {
            XB_SPIN(xb_ld(&bar[XB_XGEN(b.x)]) == gen, bar);
            __builtin_amdgcn_fence(__ATOMIC_ACQUIRE, "agent");
            asm volatile("s_waitcnt vmcnt(0)" ::: "memory");
        }
    }
    __syncthreads();
}

__device__ __forceinline__ void transpose_item(const float* W, int ldw, int K, bf16_t* WT, int k0, int n0, int dst0, LAS float* scr, int lane, int ncols) {
    const bool colok = n0 + (lane & 31) < ncols;
#pragma unroll
    for (int i = 0; i < 32; ++i) { const int kk = 2 * i + (lane >> 5); scr[kk * 33 + (lane & 31)] = colok ? W[(size_t)(k0 + kk) * ldw + n0 + (lane & 31)] : 0.f; }
    LDS_WAIT();
    const int c = lane & 7;
#pragma unroll
    for (int j = 0; j < 4; ++j) { const int n = (lane >> 3) + 8 * j; const LAS float* s = scr + (8 * c) * 33 + n;
        u32x4 o; o.x = pk(s[0 * 33], s[1 * 33]); o.y = pk(s[2 * 33], s[3 * 33]); o.z = pk(s[4 * 33], s[5 * 33]); o.w = pk(s[6 * 33], s[7 * 33]);
        *(u32x4*)(WT + (size_t)(dst0 + n) * K + k0 + 8 * c) = o; }
    LDS_WAIT();
}
__device__ __forceinline__ void ph_prologue(const int wv, const int l, LAS unsigned char* lds, const int parts, const int b0, const int nb) {
    const Args a = load_args();
    const int tid = opq_tid(wv), lane = tid & 63, wave = __builtin_amdgcn_readfirstlane(tid >> 6); const int bid = opq_bid();
    if ((parts & 1) && bid < 192) {
        LAS float* sc = (LAS float*)(lds + 73728);
        LAS float* red = (LAS float*)(lds + 110592);
        float* MOD = (float*)(a.ws + WS_MOD);
        for (int e = tid; e < 9 * 1024; e += 512) { const int mi = e >> 10, k = e & 1023; const float v = mi == 0 ? a.c_ctx[k] : a.c[(mi - 1) * 1024 + k]; sc[e] = silu_f(v); }
        __syncthreads();
        const int lay = bid / 96, n0 = (bid % 96) * 64;
        const float* W = a.w_ada + (size_t)lay * 1024 * 6144 + n0 + lane;
        float acc[9];
#pragma unroll
        for (int mi = 0; mi < 9; ++mi) acc[mi] = 0.f;
        const int kb = wave * 128;
#pragma unroll 16
        for (int k = 0; k < 128; ++k) { const float wv = W[(size_t)(kb + k) * 6144];
#pragma unroll
            for (int mi = 0; mi < 9; ++mi) acc[mi] += sc[mi * 1024 + kb + k] * wv; }
#pragma unroll
        for (int mi = 0; mi < 9; ++mi) red[(wave * 9 + mi) * 64 + lane] = acc[mi];
        __syncthreads();
        for (int t = tid; t < 576; t += 512) { const int mi = t >> 6, ln = t & 63; float s = a.b_ada[lay * 6144 + n0 + ln];
#pragma unroll
            for (int w = 0; w < 8; ++w) s += red[(w * 9 + mi) * 64 + ln];
            MOD[(size_t)(lay * 9 + mi) * 6144 + n0 + ln] = s; }
        __syncthreads();
    }
    if (parts & 2) { u32x4* z = (u32x4*)((bf16_t*)(a.ws + WS_WIN) + (size_t)3616 * 1024); const u32x4 z4 = {0u, 0u, 0u, 0u};
        for (int i = bid * 512 + tid; i < 224 * 128; i += gridDim.x * 512) z[i] = z4; }
    LAS float* scr = (LAS float*)(lds + wave * 8448);
    const int gw = (bid - b0) * 8 + wave, NGW = nb * 8;
    constexpr int I_IN = 16 * 113, I_OUT = 16 * 32, I_UP = 16 * 176, I_DN = 44 * 32;
    const int it_lo = (parts & 2) ? 0 : I_IN + I_OUT, it_hi = (parts & 4) ? I_IN + I_OUT + I_UP + I_DN : I_IN + I_OUT;
    for (int it = it_lo + gw; it < it_hi; it += NGW) {
        int r = it;
        if (r < I_IN) { const int kb = r / 113, n0 = (r % 113) * 32; int dst;
            if (n0 < 512) dst = n0; else if (n0 < 1024) { const int ch = n0 - 512; dst = 512 + (ch >> 7) * 256 + (ch & 127); }
            else if (n0 < 1536) { const int ch = n0 - 1024; dst = 512 + (ch >> 7) * 256 + 128 + (ch & 127); } else dst = n0;
            transpose_item(a.w_in + (size_t)l * 1024 * 3600, 3600, 1024, (bf16_t*)(a.ws + WS_WIN), kb * 64, n0, dst, scr, lane, 3600); continue; }
        r -= I_IN;
        if (r < I_OUT) { const int kb = r / 32, n0 = (r % 32) * 32; transpose_item(a.w_out + (size_t)l * 1024 * 1024, 1024, 1024, (bf16_t*)(a.ws + WS_WOUT), kb * 64, n0, n0, scr, lane, 1024); continue; }
        r -= I_OUT;
        if (r < I_UP) { const int kb = r / 176, n0 = (r % 176) * 32; transpose_item(a.w_up + (size_t)l * 1024 * 5632, 5632, 1024, (bf16_t*)(a.ws + WS_WUP), kb * 64, n0, n0, scr, lane, 5632); continue; }
        r -= I_UP;
        { const int kb = r / 32, n0 = (r % 32) * 32; transpose_item(a.w_down + (size_t)l * 2816 * 1024, 1024, 2816, (bf16_t*)(a.ws + WS_WDN), kb * 64, n0, n0, scr, lane, 1024); }
    }
}

__device__ __forceinline__ void ph_prep_h(const int wv, const int l, const int which, LAS unsigned char* lds) {
    const Args a = load_args();
    const int tid = opq_tid(wv), lane = tid & 63, wave = __builtin_amdgcn_readfirstlane(tid >> 6); const int bid = opq_bid();
    const int gw = bid * 8 + wave, NGW = gridDim.x * 8;
    const float* MOD = (const float*)(a.ws + WS_MOD);
    const float* nw = (which == 1 ? a.norm1_w : a.norm2_w) + l * 1024;
    bf16_t* H = (bf16_t*)(a.ws + WS_H);
    const float* WX = (const float*)(a.ws + WS_WINX);
    float* BA = (float*)(a.ws + WS_BA);
    f32x4 nwv[4];
#pragma unroll
    for (int j = 0; j < 4; ++j) nwv[j] = *(const f32x4*)(nw + 4 * (lane + 64 * j));
    for (int rowb = gw; rowb < MTOK; rowb += 2 * NGW) {
        f32x4 v[2][4]; float ss[2] = {0.f, 0.f};
#pragma unroll
        for (int u = 0; u < 2; ++u) { const int row = rowb + u * NGW; if (row < MTOK) { const float* xr;
            if (which == 1 && l == 0) xr = row < 4096 ? a.x_prompt + (size_t)row * 1024 : a.x_sample + (size_t)(row - 4096) * 1024;
            else xr = a.out + (size_t)row * 1024;
#pragma unroll
            for (int j = 0; j < 4; ++j) v[u][j] = *(const f32x4*)(xr + 4 * (lane + 64 * j)); } }
#pragma unroll
        for (int u = 0; u < 2; ++u) { const int row = rowb + u * NGW; if (row < MTOK) {
#pragma unroll
            for (int j = 0; j < 4; ++j) ss[u] += (v[u][j].x * v[u][j].x + v[u][j].y * v[u][j].y) + (v[u][j].z * v[u][j].z + v[u][j].w * v[u][j].w);
            const int mi = row < 4096 ? 0 : 1 + ((row - 4096) >> 11);
            const float* mod = MOD + (size_t)(l * 9 + mi) * 6144 + (which == 1 ? 0 : 3072);
            const float rstd = rsqrtf(wave_sum(ss[u]) * (1.f / 1024.f) + EPS);
#pragma unroll
            for (int j = 0; j < 4; ++j) { const f32x4 sh = *(const f32x4*)(mod + 4 * (lane + 64 * j)), sc = *(const f32x4*)(mod + 1024 + 4 * (lane + 64 * j));
                v[u][j] = v[u][j] * rstd * nwv[j] * (sc + 1.f) + sh;
                u32x2 o; o.x = pk(v[u][j].x, v[u][j].y); o.y = pk(v[u][j].z, v[u][j].w);
                *(u32x2*)(H + (size_t)row * 1024 + 4 * (lane + 64 * j)) = o; }
} }
    }
}

__device__ __forceinline__ void ph_conv_prep(const int wv, const int l) {
    const Args a = load_args();
    const int tid = opq_tid(wv), lane = tid & 63, wave = __builtin_amdgcn_readfirstlane(tid >> 6); const int bid = opq_bid();
    const int gw = bid * 8 + wave, NGW = gridDim.x * 8;
    const bf16_t* CB = (const bf16_t*)(a.ws + WS_CB); const bf16_t* P = (const bf16_t*)(a.ws + WS_P); const bf16_t* ZQ = (const bf16_t*)(a.ws + WS_ZQ);
    bf16_t* A = (bf16_t*)(a.ws + WS_H); bf16_t* QKVN = (bf16_t*)(a.ws + WS_QKVN);
    const float* wa = a.conv_a_w + (size_t)l * 3 * 512; const float* wq = a.qkv_conv_w + (size_t)l * 3 * 1536;
    const u32x4 zero4 = {0u, 0u, 0u, 0u};
    for (int rowb = gw; rowb < MTOK; rowb += 2 * NGW) {
        u32x4 pc[2], pl[2], pr[2], cb[2], zc[2][3], zl[2][3], zr[2][3];
#pragma unroll
        for (int u = 0; u < 2; ++u) { const int row = rowb + u * NGW; if (row < MTOK) {
            int pos, rl; if (row < 4096) { pos = row & 255; rl = 256; } else { pos = (row - 4096) & 63; rl = 64; }
            const bool hasL = pos > 0, hasR = pos < rl - 1;
            const bf16_t* pp = P + (size_t)row * 512 + lane * 8;
            pc[u] = *(const u32x4*)pp; pl[u] = hasL ? *(const u32x4*)(pp - 512) : zero4; pr[u] = hasR ? *(const u32x4*)(pp + 512) : zero4; cb[u] = *(const u32x4*)(CB + (size_t)row * 512 + lane * 8);
#pragma unroll
            for (int seg = 0; seg < 3; ++seg) { const bf16_t* zp = ZQ + (size_t)row * 1536 + seg * 512 + lane * 8;
                zc[u][seg] = *(const u32x4*)zp; zl[u][seg] = hasL ? *(const u32x4*)(zp - 1536) : zero4; zr[u][seg] = hasR ? *(const u32x4*)(zp + 1536) : zero4; } } }
#pragma unroll
        for (int u = 0; u < 2; ++u) { const int row = rowb + u * NGW; if (row < MTOK) {
            { const int c = lane * 8;
                float w0[8], w1[8], w2[8], fl[8], fc[8], fr[8], fb[8], y[8];
                load8f(wa + c, w0); load8f(wa + 512 + c, w1); load8f(wa + 1024 + c, w2);
                unpack8(pl[u], fl); unpack8(pc[u], fc); unpack8(pr[u], fr); unpack8(cb[u], fb);
#pragma unroll
                for (int e = 0; e < 8; ++e) y[e] = fb[e] * (w0[e] * fl[e] + w1[e] * fc[e] + w2[e] * fr[e]);
                *(u32x4*)(A + (size_t)row * 1024 + c) = pack8(y); }
#pragma unroll
            for (int seg = 0; seg < 3; ++seg) { const int c = seg * 512 + lane * 8;
                float w0[8], w1[8], w2[8], fl[8], fc[8], fr[8], x[8];
                load8f(wq + c, w0); load8f(wq + 1536 + c, w1); load8f(wq + 3072 + c, w2);
                unpack8(zl[u][seg], fl); unpack8(zc[u][seg], fc); unpack8(zr[u][seg], fr);
                float ss = 0.f;
#pragma unroll
                for (int e = 0; e < 8; ++e) { x[e] = silu_f(w0[e] * fl[e] + w1[e] * fc[e] + w2[e] * fr[e]); ss += x[e] * x[e]; }
                if (seg < 2) { ss += __shfl_xor(ss, 1); ss += __shfl_xor(ss, 2); ss += __shfl_xor(ss, 4); ss += __shfl_xor(ss, 8);
                    const float sc = rsqrtf(ss + EPS) * (seg == 0 ? 0.08838834764831845f : 1.f);
#pragma unroll
                    for (int e = 0; e < 8; ++e) x[e] *= sc; }
                *(u32x4*)(QKVN + (size_t)row * 1536 + c) = pack8(x); } } }
    }
}

template <int RI, int HF> __device__ __forceinline__ void inv_seg_load(f32x4 (&dst)[8], const LAS float* Lm) {
#pragma unroll
    for (int jj = 0; jj < 8; ++jj) if (HF * 32 + jj * 4 < RI) dst[jj] = *(const LAS f32x4*)(Lm + RI * 64 + HF * 32 + jj * 4);
}
template <int I, int HF> __device__ __forceinline__ void inv_seg(float (&t)[64], f32x4 (&Lr)[2][8], const LAS float* Lm, float& a0, float& a1, float& a2, float& a3, float& last) {
    constexpr int SIDX = (I <= 32) ? I : 32 + 2 * (I - 32) - 1 + HF;
    constexpr int NI = (HF == 0 && I > 32) ? I : I + 1, NH = (HF == 0 && I > 32) ? 1 : 0;
    if constexpr (NI < 64) inv_seg_load<NI, NH>(Lr[(SIDX + 1) & 1], Lm);
    __builtin_amdgcn_sched_barrier(0);
#pragma unroll
    for (int jj = 0; jj < 8; ++jj) { const int j0 = HF * 32 + jj * 4; if (j0 < I) { const f32x4 l4 = Lr[SIDX & 1][jj];
        if (j0 + 0 < I - 1) a0 -= l4.x * t[j0 + 0]; else if (j0 + 0 == I - 1) last = l4.x;
        if (j0 + 1 < I - 1) a1 -= l4.y * t[(j0 + 1) & 63]; else if (j0 + 1 == I - 1) last = l4.y;
        if (j0 + 2 < I - 1) a2 -= l4.z * t[(j0 + 2) & 63]; else if (j0 + 2 == I - 1) last = l4.z;
        if (j0 + 3 < I - 1) a3 -= l4.w * t[(j0 + 3) & 63]; else if (j0 + 3 == I - 1) last = l4.w; } }
    __builtin_amdgcn_sched_barrier(0);
}
template <int I> __device__ __forceinline__ void inv_rows(float (&t)[64], f32x4 (&Lr)[2][8], const LAS float* Lm, bf16_t* To, const int lane) {
    if constexpr (I < 64) {
        float a0 = 0.f, a1 = 0.f, a2 = 0.f, a3 = 0.f, last = 0.f;
        if constexpr (I > 0) inv_seg<I, 0>(t, Lr, Lm, a0, a1, a2, a3, last);
        if constexpr (I > 32) inv_seg<I, 1>(t, Lr, Lm, a0, a1, a2, a3, last);
        float acc = ((I == lane) ? 1.f : 0.f) + ((a0 + a1) + (a2 + a3));
        if constexpr (I > 0) acc -= last * t[I - 1];
        t[I] = acc; To[I * 64] = f2bf(acc);
        inv_rows<I + 1>(t, Lr, Lm, To, lane);
    }
}
__device__ __forceinline__ void ph_pre(const int wv, const int l, LAS unsigned char* lds) {
    const Args a = load_args();
    const int tid = opq_tid(wv), lane = tid & 63, wave = __builtin_amdgcn_readfirstlane(tid >> 6); const int bid = opq_bid();
    const bf16_t* QKVN = (const bf16_t*)(a.ws + WS_QKVN); const float* BA = (const float*)(a.ws + WS_BA);
    float* GC = (float*)(a.ws + WS_GC); float* BT = (float*)(a.ws + WS_BT); bf16_t* TQK = (bf16_t*)(a.ws + WS_TQK);
    const int hb = wave >> 2, w4 = wave & 3, t256 = tid & 255;
    LAS unsigned char* lb = lds + hb * 69632;
    LAS unsigned char* sK = lb; LAS unsigned char* sQ = lb + 17408;
    LAS float* sGram = (LAS float*)(lb + 34816); LAS float* sQK = (LAS float*)(lb + 51456);
    LAS float* sL = (LAS float*)lb;
    LAS float* sG = (LAS float*)(lb + 68096); LAS float* sB = (LAS float*)(lb + 68608);
    for (int it2 = bid; it2 < 640; it2 += gridDim.x) {
        const int it = it2 * 2 + hb;
        const int gc = it >> 2, h = it & 3, r0 = gc * 64;
#pragma unroll
        for (int rep = 0; rep < 4; ++rep) { const int ch = t256 + rep * 256, row = ch >> 4, c16 = ch & 15;
            const bf16_t* src = QKVN + (size_t)(r0 + row) * 1536 + h * 128 + c16 * 8;
            *(LAS u32x4*)(sQ + row * 272 + c16 * 16) = *(const u32x4*)src;
            *(LAS u32x4*)(sK + row * 272 + c16 * 16) = *(const u32x4*)(src + 512); }
        if (w4 < 2) { const int d = w4, i = d ? 63 - lane : lane, row = r0 + i;
            const float bl = BA[(size_t)row * 16 + d * 4 + h], ai = BA[(size_t)row * 16 + 8 + d * 4 + h];
            const float beta = 1.f / (1.f + __expf(-bl));
            const float xx = ai + a.dt_bias[l * 8 + d * 4 + h];
            const float sp = fmaxf(xx, 0.f) + __logf(1.f + __expf(-fabsf(xx)));
            float g = -__expf(a.a_log[l * 8 + d * 4 + h]) * sp;
#pragma unroll
            for (int off = 1; off < 64; off <<= 1) { const float t = __shfl_up(g, off); if (lane >= off) g += t; }
            sG[d * 64 + lane] = g; sB[d * 64 + lane] = beta; GC[(size_t)row * 8 + d * 4 + h] = g; BT[(size_t)row * 8 + d * 4 + h] = beta; }
        __syncthreads();
        f32x16 acc2[2];
#pragma unroll
        for (int k2 = 0; k2 < 2; ++k2) { const int t8 = w4 * 2 + k2, mi = (t8 >> 1) & 1, ni = t8 & 1, r = lane & 31, hh = lane >> 5; const LAS unsigned char* sA = t8 < 4 ? sK : sQ;
#pragma unroll
            for (int i = 0; i < 16; ++i) acc2[k2][i] = 0.f;
#pragma unroll
            for (int kk = 0; kk < 8; ++kk) { const bf16x8 av = *(const LAS bf16x8*)(sA + (mi * 32 + r) * 272 + (kk * 16 + 8 * hh) * 2);
                const bf16x8 bv = *(const LAS bf16x8*)(sK + (ni * 32 + r) * 272 + (kk * 16 + 8 * hh) * 2); acc2[k2] = MFMA32(av, bv, acc2[k2]); } }
#pragma unroll
        for (int k2 = 0; k2 < 2; ++k2) { const int t8 = w4 * 2 + k2, mi = (t8 >> 1) & 1, ni = t8 & 1, r = lane & 31, hh = lane >> 5;
            LAS float* dst = t8 < 4 ? sGram : sQK;
#pragma unroll
            for (int reg = 0; reg < 16; ++reg) { const int i = mi * 32 + (reg & 3) + 8 * (reg >> 2) + 4 * hh, j = ni * 32 + r; dst[i * 65 + j] = acc2[k2][reg]; } }
        __syncthreads();
        for (int e = t256; e < 8192; e += 256) { const int d = e >> 12, p = (e >> 6) & 63, q = e & 63; const int i = d ? 63 - p : p, j = d ? 63 - q : q;
            const float dec = p >= q ? __expf(sG[d * 64 + p] - sG[d * 64 + q]) : 0.f;
            sL[e] = p > q ? sB[d * 64 + p] * sGram[i * 65 + j] * dec : 0.f;
            TQK[(size_t)(it * 2 + d) * 8192 + 4096 + p * 64 + ((q & 32) + 8 * ((q >> 2) & 3) + 4 * ((q >> 4) & 1) + (q & 3))] = f2bf(sQK[i * 65 + j] * dec); }
        __syncthreads();
        if (w4 < 2) { const int d = w4; const LAS float* Lm = sL + d * 4096; bf16_t* To = TQK + (size_t)(it * 2 + d) * 8192 + ((lane & 32) + 8 * ((lane >> 2) & 3) + 4 * ((lane >> 4) & 1) + (lane & 3));
            float t[64]; f32x4 Lr[2][8];
            inv_seg_load<1, 0>(Lr[1], Lm);
            inv_rows<0>(t, Lr, Lm, To, lane);
        }
        __syncthreads();
    }
}

#define MFMA16(a, b, c) __builtin_amdgcn_mfma_f32_16x16x32_bf16((a), (b), (c), 0, 0, 0)
__device__ __forceinline__ bf16x8 pack_b(const f32x4 lo, const f32x4 hi) { u32x4 w; w.x = pk(lo[0], lo[1]); w.y = pk(lo[2], lo[3]); w.z = pk(hi[0], hi[1]); w.w = pk(hi[2], hi[3]); return __builtin_bit_cast(bf16x8, w); }
__device__ __forceinline__ void ph_scan(const int wv, const int l, LAS unsigned char* lds) {
    const Args a = load_args();
    const int tid = opq_tid(wv), lane = tid & 63, wave = __builtin_amdgcn_readfirstlane(tid >> 6); const int bid = opq_bid();
    if (bid >= 256) return;
    int r0, nch, h, d, sidx, ncw, dvbase; bool lat;
    if (bid < 128) { lat = true; const int it = (bid >> 4) * 8 + (bid & 7); sidx = it >> 3; h = (it >> 1) & 3; d = it & 1; r0 = 4096 + sidx * 2048; nch = 32; ncw = 4; dvbase = ((bid >> 3) & 1) * 64; }
    else { lat = false; const int it = bid - 128; sidx = it >> 3; h = (it >> 1) & 3; d = it & 1; r0 = sidx * 256; nch = 4; ncw = 8; dvbase = 0; }
    const bf16_t* QKVN = (const bf16_t*)(a.ws + WS_QKVN); const float* GC = (const float*)(a.ws + WS_GC); const float* BT = (const float*)(a.ws + WS_BT);
    const bf16_t* TQK = (const bf16_t*)(a.ws + WS_TQK); bf16_t* OD = (bf16_t*)(a.ws + (d ? WS_OB : WS_OF));
    constexpr int BUFB = 72464, O_KB = 0, O_QD = 17408, O_KE = 34816, O_T = 53248, O_QK = 62464, O_BT = 71680, O_EG = 71952, O_EK = 72208;
    const bool cw = wave < ncw;
    const int c16 = lane & 15, g = lane >> 4;
    const int dv = dvbase + wave * 16 + c16;
    const bool fillA = lat ? (wave >= 4) : true, fillB = lat && (wave >= 4);
    const int slotA = lat ? tid - 256 : tid, slotB = slotA + 256;
    const int pA = slotA >> 3, partA = slotA & 7, ipA = d ? 63 - pA : pA, pB = slotB >> 3, partB = slotB & 7, ipB = d ? 63 - pB : pB;
    u32x4 pk0A, pk1A, pq0A, pq1A, pTA, pQA, pk0B, pk1B, pq0B, pq1B, pTB, pQB; float pgA, pbetaA, pglastA, pgB, pbetaB, pglastB; bf16_t pv[16]; unsigned osv[8]; unsigned gprev = 0u;
#define LOADG(n, X) do { const int cn_ = d ? nch - 1 - (n) : (n); const unsigned gcn_ = (unsigned)((r0 >> 6) + cn_); const unsigned row_ = gcn_ * 64u + (unsigned)ip##X; \
        const unsigned qo_ = row_ * 1536u + (unsigned)(h * 128 + part##X * 16); pq0##X = *(const u32x4*)(QKVN + qo_); pq1##X = *(const u32x4*)(QKVN + qo_ + 8u); pk0##X = *(const u32x4*)(QKVN + qo_ + 512u); pk1##X = *(const u32x4*)(QKVN + qo_ + 520u); \
        pg##X = GC[row_ * 8u + (unsigned)(d * 4 + h)]; pbeta##X = BT[row_ * 8u + (unsigned)(d * 4 + h)]; pglast##X = GC[(gcn_ * 64u + (d ? 0u : 63u)) * 8u + (unsigned)(d * 4 + h)]; \
        const unsigned to_ = ((gcn_ * 4u + (unsigned)h) * 2u + (unsigned)d) * 8192u + (unsigned)slot##X * 8u; pT##X = *(const u32x4*)(TQK + to_); pQ##X = *(const u32x4*)(TQK + to_ + 4096u); } while (0)
#define LOADV(n) do { const int cn_ = d ? nch - 1 - (n) : (n); const unsigned gcn_ = (unsigned)((r0 >> 6) + cn_); \
        _Pragma("unroll") for (int q_ = 0; q_ < 16; ++q_) { const int pp_ = 16 * (q_ >> 2) + 4 * g + (q_ & 3), ii_ = d ? 63 - pp_ : pp_; \
            pv[q_] = QKVN[(gcn_ * 64u + (unsigned)ii_) * 1536u + (unsigned)(1024 + h * 128 + dv)]; } } while (0)
#define STOREO() do { _Pragma("unroll") for (int q_ = 0; q_ < 16; ++q_) { const int pp_ = 16 * (q_ >> 2) + 4 * g + (q_ & 3), ii_ = d ? 63 - pp_ : pp_; \
            OD[(gprev * 64u + (unsigned)ii_) * 512u + (unsigned)(h * 128 + dv)] = (bf16_t)((q_ & 1) ? (osv[q_ >> 1] >> 16) : (osv[q_ >> 1] & 0xffffu)); } } while (0)
#define FILL(B, X) do { LAS unsigned char* b_ = lds + (B) * BUFB; \
          \
        { const int bo_ = p##X * 272 + (32 * (part##X >> 1) + 4 * (part##X & 1)) * 2; \
            *(LAS u32x2*)(b_ + O_KB + bo_) = (u32x2){pk0##X.x, pk0##X.y}; *(LAS u32x2*)(b_ + O_KB + bo_ + 16) = (u32x2){pk0##X.z, pk0##X.w}; \
            *(LAS u32x2*)(b_ + O_KB + bo_ + 32) = (u32x2){pk1##X.x, pk1##X.y}; *(LAS u32x2*)(b_ + O_KB + bo_ + 48) = (u32x2){pk1##X.z, pk1##X.w}; \
            *(LAS u32x2*)(b_ + O_QD + bo_) = (u32x2){pq0##X.x, pq0##X.y}; *(LAS u32x2*)(b_ + O_QD + bo_ + 16) = (u32x2){pq0##X.z, pq0##X.w}; \
            *(LAS u32x2*)(b_ + O_QD + bo_ + 32) = (u32x2){pq1##X.x, pq1##X.y}; *(LAS u32x2*)(b_ + O_QD + bo_ + 48) = (u32x2){pq1##X.z, pq1##X.w}; } \
        { const int pp_ = (p##X & 32) + 8 * ((p##X >> 2) & 3) + 4 * ((p##X >> 4) & 1) + (p##X & 3); const int pos_ = ((((pp_ >> 3) ^ part##X) << 3) | (pp_ & 7)); \
            LAS bf16_t* ke_ = (LAS bf16_t*)(b_ + O_KE) + (part##X * 16) * 72 + pos_; \
            ke_[0 * 72] = (bf16_t)(pk0##X.x & 0xffffu); ke_[1 * 72] = (bf16_t)(pk0##X.x >> 16); ke_[2 * 72] = (bf16_t)(pk0##X.y & 0xffffu); ke_[3 * 72] = (bf16_t)(pk0##X.y >> 16); \
            ke_[4 * 72] = (bf16_t)(pk0##X.z & 0xffffu); ke_[5 * 72] = (bf16_t)(pk0##X.z >> 16); ke_[6 * 72] = (bf16_t)(pk0##X.w & 0xffffu); ke_[7 * 72] = (bf16_t)(pk0##X.w >> 16); \
            ke_[8 * 72] = (bf16_t)(pk1##X.x & 0xffffu); ke_[9 * 72] = (bf16_t)(pk1##X.x >> 16); ke_[10 * 72] = (bf16_t)(pk1##X.y & 0xffffu); ke_[11 * 72] = (bf16_t)(pk1##X.y >> 16); \
            ke_[12 * 72] = (bf16_t)(pk1##X.z & 0xffffu); ke_[13 * 72] = (bf16_t)(pk1##X.z >> 16); ke_[14 * 72] = (bf16_t)(pk1##X.w & 0xffffu); ke_[15 * 72] = (bf16_t)(pk1##X.w >> 16); } \
        *(LAS u32x4*)(b_ + O_T + p##X * 144 + part##X * 16) = pT##X; *(LAS u32x4*)(b_ + O_QK + p##X * 144 + part##X * 16) = pQ##X; \
        if (part##X == 0) { ((LAS float*)(b_ + O_BT))[p##X] = pbeta##X; ((LAS float*)(b_ + O_EG))[p##X] = __expf(pg##X); ((LAS float*)(b_ + O_EK))[p##X] = __expf(pglast##X - pg##X); } \
        if (slot##X == 0) ((LAS float*)(b_ + O_BT))[64] = __expf(pglast##X); } while (0)
#define SCHED() __builtin_amdgcn_sched_barrier(0)
#define LDKQ(slot, b) do { const int off_ = ((b) & 1 ? O_QD : O_KB) + rowK + 64 * ((b) >> 1); _Pragma("unroll") for (int pt = 0; pt < 4; ++pt) fA[slot][pt] = *(const LAS bf16x8*)(B + off_ + pt * 16 * 272); } while (0)
#define LDKE(slot, b) do { _Pragma("unroll") for (int tt = 0; tt < 4; ++tt) { const int t_ = 4 * ((b) & 1) + tt; fE[slot][tt] = *(const LAS bf16x8*)(B + O_KE + (16 * t_ + c16) * 144 + (((4 * ((b) >> 1) + g) ^ t_) << 4)); } } while (0)
#define COMPUTE(n) do { \
            const LAS unsigned char* B = lds + (n & 1) * BUFB; \
            const float decay = ((const LAS float*)(B + O_BT))[64]; \
            const int rowK = c16 * 272 + 16 * g, rowT = c16 * 144 + 16 * g; \
            bf16x8 Sb[4]; \
            _Pragma("unroll") \
            for (int s4 = 0; s4 < 4; ++s4) Sb[s4] = pack_b(accS[2 * s4], accS[2 * s4 + 1]); \
            f32x4 accR[4], accO[4]; \
            _Pragma("unroll") \
            for (int pt = 0; pt < 4; ++pt) { accR[pt] = (f32x4){0.f, 0.f, 0.f, 0.f}; accO[pt] = (f32x4){0.f, 0.f, 0.f, 0.f}; } \
            if (n > 0) STOREO();                            \
            bf16x8 fA[2][4]; \
            LDKQ(0, 0); \
            bf16x8 fT[6], fQK[6]; \
            _Pragma("unroll") \
            for (int b = 0; b < 8; ++b) { \
                if (b < 7) LDKQ((b + 1) & 1, b + 1); \
                else { \
                    fT[0] = *(const LAS bf16x8*)(B + O_T + rowT); fT[1] = *(const LAS bf16x8*)(B + O_T + rowT + 16 * 144); fT[2] = *(const LAS bf16x8*)(B + O_T + rowT + 32 * 144); \
                    fT[3] = *(const LAS bf16x8*)(B + O_T + rowT + 32 * 144 + 64); fT[4] = *(const LAS bf16x8*)(B + O_T + rowT + 48 * 144); fT[5] = *(const LAS bf16x8*)(B + O_T + rowT + 48 * 144 + 64); \
                } \
                SCHED(); \
                if (b & 1) { \
            _Pragma("unroll") \
                    for (int pt = 0; pt < 4; ++pt) accO[pt] = MFMA16(fA[b & 1][pt], Sb[b >> 1], accO[pt]); \
                } else { \
            _Pragma("unroll") \
                    for (int pt = 0; pt < 4; ++pt) accR[pt] = MFMA16(fA[b & 1][pt], Sb[b >> 1], accR[pt]); \
                } \
                SCHED(); \
            } \
            fQK[0] = *(const LAS bf16x8*)(B + O_QK + rowT); fQK[1] = *(const LAS bf16x8*)(B + O_QK + rowT + 16 * 144); fQK[2] = *(const LAS bf16x8*)(B + O_QK + rowT + 32 * 144); \
            fQK[3] = *(const LAS bf16x8*)(B + O_QK + rowT + 32 * 144 + 64); fQK[4] = *(const LAS bf16x8*)(B + O_QK + rowT + 48 * 144); fQK[5] = *(const LAS bf16x8*)(B + O_QK + rowT + 48 * 144 + 64); \
            _Pragma("unroll") \
            for (int pt = 0; pt < 4; ++pt) { const f32x4 bt = *(const LAS f32x4*)(B + O_BT + (16 * pt + 4 * g) * 4), eg = *(const LAS f32x4*)(B + O_EG + (16 * pt + 4 * g) * 4); \
                _Pragma("unroll") \
                for (int rg = 0; rg < 4; ++rg) { accR[pt][rg] = bt[rg] * (bf2f(pv[4 * pt + rg]) - eg[rg] * accR[pt][rg]); accO[pt][rg] *= eg[rg]; } } \
            bf16x8 Rb[2]; Rb[0] = pack_b(accR[0], accR[1]); Rb[1] = pack_b(accR[2], accR[3]); \
            if (n + 1 < nch) LOADV(n + 1); \
            f32x4 accV[4]; \
            _Pragma("unroll") \
            for (int pt = 0; pt < 4; ++pt) accV[pt] = (f32x4){0.f, 0.f, 0.f, 0.f}; \
            SCHED(); \
            accV[0] = MFMA16(fT[0], Rb[0], accV[0]); accV[1] = MFMA16(fT[1], Rb[0], accV[1]); accV[2] = MFMA16(fT[2], Rb[0], accV[2]); accV[3] = MFMA16(fT[4], Rb[0], accV[3]); \
            accV[2] = MFMA16(fT[3], Rb[1], accV[2]); accV[3] = MFMA16(fT[5], Rb[1], accV[3]); \
            SCHED(); \
            bf16x8 fE[2][4]; \
            LDKE(0, 0); \
            bf16x8 Vb[2]; Vb[0] = pack_b(accV[0], accV[1]); Vb[1] = pack_b(accV[2], accV[3]); \
            bf16x8 Ve[2]; \
            { f32x4 ev[4]; \
                _Pragma("unroll") \
                for (int pt = 0; pt < 4; ++pt) ev[pt] = accV[pt] * *(const LAS f32x4*)(B + O_EK + (16 * pt + 4 * g) * 4); \
                Ve[0] = pack_b(ev[0], ev[1]); Ve[1] = pack_b(ev[2], ev[3]); } \
            SCHED(); \
            accO[0] = MFMA16(fQK[0], Vb[0], accO[0]); accO[1] = MFMA16(fQK[1], Vb[0], accO[1]); accO[2] = MFMA16(fQK[2], Vb[0], accO[2]); accO[3] = MFMA16(fQK[4], Vb[0], accO[3]); \
            accO[2] = MFMA16(fQK[3], Vb[1], accO[2]); accO[3] = MFMA16(fQK[5], Vb[1], accO[3]); \
            _Pragma("unroll") \
            for (int t = 0; t < 8; ++t) accS[t] = accS[t] * decay; \
            _Pragma("unroll") \
            for (int b = 0; b < 4; ++b) {            \
                if (b < 3) LDKE((b + 1) & 1, b + 1); \
                SCHED(); \
            _Pragma("unroll") \
                for (int tt = 0; tt < 4; ++tt) accS[4 * (b & 1) + tt] = MFMA16(fE[b & 1][tt], Ve[b >> 1], accS[4 * (b & 1) + tt]); \
                SCHED(); \
            } \
            _Pragma("unroll") \
            for (int pt = 0; pt < 4; ++pt) { osv[2 * pt] = pk(accO[pt][0], accO[pt][1]); osv[2 * pt + 1] = pk(accO[pt][2], accO[pt][3]); } \
            gprev = gcur; \
        } while (0)
    if (lat && wave >= 4) {
        LOADG(0, A); LOADG(0, B); FILL(0, A); FILL(0, B); LOADG(1, A); LOADG(1, B);
        __syncthreads();
        for (int n = 0; n < nch; ++n) {
            if (n + 1 < nch) { FILL((n + 1) & 1, A); FILL((n + 1) & 1, B); }
            if (n + 2 < nch) { LOADG(n + 2, A); LOADG(n + 2, B); }
            __syncthreads();
        }
    } else if (lat) {
        f32x4 accS[8];
#pragma unroll
        for (int t = 0; t < 8; ++t)
#pragma unroll
            for (int reg = 0; reg < 4; ++reg) { const int dk = 16 * t + 4 * g + reg; accS[t][reg] = a.state[((size_t)(((sidx * 2 + l) * 2 + d) * 4 + h) * 128 + dk) * 128 + dv]; }
        LOADV(0);
        __syncthreads();
        for (int n = 0; n < nch; ++n) {
            const unsigned gcur = (unsigned)((r0 >> 6) + (d ? nch - 1 - n : n));
            COMPUTE(n);
            __syncthreads();
        }
        STOREO();
    } else {
        f32x4 accS[8];
#pragma unroll
        for (int t = 0; t < 8; ++t) accS[t] = (f32x4){0.f, 0.f, 0.f, 0.f};
        LOADG(0, A); LOADV(0); FILL(0, A);
        __syncthreads();
        for (int n = 0; n < nch; ++n) {
            const unsigned gcur = (unsigned)((r0 >> 6) + (d ? nch - 1 - n : n));
            if (n + 1 < nch) { LOADG(n + 1, A); FILL((n + 1) & 1, A); }
            COMPUTE(n);
            __syncthreads();
        }
        STOREO();
        { float* ns = a.out + (size_t)MTOK * 1024 + (size_t)(((sidx * 2 + l) * 2 + d) * 4 + h) * 16384;
#pragma unroll
            for (int t = 0; t < 8; ++t)
#pragma unroll
                for (int reg = 0; reg < 4; ++reg) { const int dk = 16 * t + 4 * g + reg; ns[dk * 128 + dv] = accS[t][reg]; } }
    }
#undef COMPUTE
#undef LDKQ
#undef LDKE
#undef SCHED
#undef STOREO
    if (!lat) { __syncthreads(); ph_prologue(wv, l, lds, 4, 128, 128); }
#undef LOADG
#undef LOADV
#undef FILL
}

__device__ __forceinline__ void ph_mix_prep(const int wv, const int l) {
    const Args a = load_args();
    const int tid = opq_tid(wv), lane = tid & 63, wave = __builtin_amdgcn_readfirstlane(tid >> 6); const int bid = opq_bid();
    const int gw = bid * 8 + wave, NGW = gridDim.x * 8;
    const bf16_t* OF = (const bf16_t*)(a.ws + WS_OF); const bf16_t* OB = (const bf16_t*)(a.ws + WS_OB); const bf16_t* ZG = (const bf16_t*)(a.ws + WS_ZG);
    bf16_t* A = (bf16_t*)(a.ws + WS_H);
    float onw[8]; load8f(a.o_norm_w + l * 128 + (lane & 15) * 8, onw);
    const int c = lane * 8;
    for (int rowb = gw; rowb < MTOK; rowb += 8 * NGW) {
        u32x4 lf[8], lb[8], lg[8];
#pragma unroll
        for (int u = 0; u < 8; ++u) { const int row = rowb + u * NGW; if (row < MTOK) { lf[u] = *(const u32x4*)(OF + (size_t)row * 512 + c); lb[u] = *(const u32x4*)(OB + (size_t)row * 512 + c); lg[u] = *(const u32x4*)(ZG + (size_t)row * 512 + c); } }
#pragma unroll
        for (int u = 0; u < 8; ++u) { const int row = rowb + u * NGW; if (row < MTOK) {
            float f[8], b[8], g[8], y[8];
            unpack8(lf[u], f); unpack8(lb[u], b); unpack8(lg[u], g);
            float ss = 0.f;
#pragma unroll
            for (int e = 0; e < 8; ++e) { f[e] += b[e]; ss += f[e] * f[e]; }
            ss += __shfl_xor(ss, 1); ss += __shfl_xor(ss, 2); ss += __shfl_xor(ss, 4); ss += __shfl_xor(ss, 8);
            const float rstd = rsqrtf(ss * (1.f / 128.f) + EPS);
#pragma unroll
            for (int e = 0; e < 8; ++e) y[e] = f[e] * rstd * onw[e] * silu_f(g[e]);
            *(u32x4*)(A + (size_t)row * 1024 + 512 + c) = pack8(y); } }
    }
}

__device__ __forceinline__ void ph_act(const int wv, const int l, const int half) {
    const Args a = load_args();
    const int tid = opq_tid(wv); const int bid = opq_bid(); const int hb = half * 10240;
    const bf16_t* UP = (const bf16_t*)(a.ws + WS_UP); bf16_t* ACT = (bf16_t*)(a.ws + WS_ACT);
    const float* cw = a.ffn_conv_w + (size_t)l * 9 * 2816;
    const u32x4 zero4 = {0u, 0u, 0u, 0u};
    const int xg = bid & 7, nloc = (int)(gridDim.x >> 3) * 512;
    for (int itl = (bid >> 3) * 512 + tid; itl < 640 * 44; itl += nloc) {
        const int seg = itl / 44, c = (xg * 44 + itl % 44) * 8; const int rs = hb + seg * 16;
        int pos0, rl; bool up_ok, dn_ok;
        if (rs < 4096) { pos0 = rs & 255; rl = 256; up_ok = false; dn_ok = false; }
        else { const int ts = (rs - 4096) & 2047, gr = ts >> 6; pos0 = ts & 63; rl = 64; up_ok = gr > 0; dn_ok = gr < 31; }
        const bf16_t* g0 = UP + (size_t)(rs - hb) * 5632 + 2816 + c;
        float w[3][3][8];
#pragma unroll
        for (int dr = 0; dr < 3; ++dr)
#pragma unroll
            for (int dc = 0; dc < 3; ++dc) load8f(cw + (dr * 3 + dc) * 2816 + c, w[dr][dc]);
        u32x4 col[20][3]; u32x4 us[16];
#define LOADCOL(X, t) do { const int ps_ = pos0 + (t); const bool ok_ = ps_ >= 0 && ps_ < rl; const bf16_t* gp_ = g0 + (ptrdiff_t)(t) * 5632; \
        X[1] = ok_ ? *(const u32x4*)gp_ : zero4; X[0] = (ok_ && up_ok) ? *(const u32x4*)(gp_ - 64 * 5632) : zero4; X[2] = (ok_ && dn_ok) ? *(const u32x4*)(gp_ + 64 * 5632) : zero4; } while (0)
        const bf16_t* u0 = UP + (size_t)(rs - hb) * 5632 + c;
        LOADCOL(col[0], -1); LOADCOL(col[1], 0); LOADCOL(col[2], 1);
        us[0] = __builtin_nontemporal_load((const u32x4*)u0); us[1] = __builtin_nontemporal_load((const u32x4*)(u0 + 5632));
#pragma unroll
        for (int t = 0; t < 16; ++t) { if (t + 2 <= 16) LOADCOL(col[t + 3], t + 2);
            if (t + 2 < 16) us[t + 2] = __builtin_nontemporal_load((const u32x4*)(u0 + (size_t)(t + 2) * 5632));
            float s[8];
#pragma unroll
            for (int e = 0; e < 8; ++e) s[e] = 0.f;
#pragma unroll
            for (int dr = 0; dr < 3; ++dr) { float fa[8], fb[8], fc[8]; unpack8(col[t][dr], fa); unpack8(col[t + 1][dr], fb); unpack8(col[t + 2][dr], fc);
#pragma unroll
                for (int e = 0; e < 8; ++e) s[e] += w[dr][0][e] * fa[e] + w[dr][1][e] * fb[e] + w[dr][2][e] * fc[e]; }
            float fu[8], y[8]; unpack8(us[t], fu);
#pragma unroll
            for (int e = 0; e < 8; ++e) { const float x = s[e], z = 0.7978845608028654f * (x + 0.044715f * x * x * x); y[e] = x / (1.f + __expf(-2.f * z)) * fu[e]; }
            __builtin_nontemporal_store(pack8(y), (u32x4*)(ACT + (size_t)(rs - hb + t) * 2816 + c));
            asm volatile("" ::: "memory"); }
#undef LOADCOL
    }
}

__device__ __forceinline__ void ph_final(const int wv) {
    const Args a = load_args();
    const int tid = opq_tid(wv), lane = tid & 63, wave = __builtin_amdgcn_readfirstlane(tid >> 6); const int bid = opq_bid();
    const int gw = bid * 8 + wave, NGW = gridDim.x * 8;
    f32x4 nwv[4];
#pragma unroll
    for (int j = 0; j < 4; ++j) nwv[j] = *(const f32x4*)(a.final_norm_w + 4 * (lane + 64 * j));
    for (int rowb = gw; rowb < MTOK; rowb += 4 * NGW) {
        f32x4 v[4][4];
#pragma unroll
        for (int u = 0; u < 4; ++u) { const int row = rowb + u * NGW; if (row < MTOK) {
#pragma unroll
            for (int j = 0; j < 4; ++j) v[u][j] = *(const f32x4*)(a.out + (size_t)row * 1024 + 4 * (lane + 64 * j)); } }
#pragma unroll
        for (int u = 0; u < 4; ++u) { const int row = rowb + u * NGW; if (row < MTOK) { float ss = 0.f;
#pragma unroll
            for (int j = 0; j < 4; ++j) ss += (v[u][j].x * v[u][j].x + v[u][j].y * v[u][j].y) + (v[u][j].z * v[u][j].z + v[u][j].w * v[u][j].w);
            const float rstd = rsqrtf(wave_sum(ss) * (1.f / 1024.f) + EPS);
#pragma unroll
            for (int j = 0; j < 4; ++j) *(f32x4*)(a.out + (size_t)row * 1024 + 4 * (lane + 64 * j)) = v[u][j] * rstd * nwv[j]; } }
    }
}

__global__ void __launch_bounds__(512, 2) mega_fwd(Args a_unused) {
    extern __shared__ __attribute__((aligned(16))) unsigned char lds_raw[];
    LAS unsigned char* lds = (LAS unsigned char*)lds_raw;
    cg::grid_group grid = cg::this_grid();
    const int G = gridDim.x;
    const int wv = __builtin_amdgcn_readfirstlane((int)threadIdx.x >> 6);
    XcdBarrier bar;
    {
        const Args a0 = load_args(); unsigned* barw = (unsigned*)(a0.ws + WS_BAR);
        volatile LAS unsigned* st = (volatile LAS unsigned*)(lds + 147440);
        const int tid0 = opq_tid(wv);
        if (tid0 == 0) { st[0] = 0u; st[1] = 0u; }
        __syncthreads();
        bar = xcd_barrier_post(barw, st, wv);
        if (G == 0x7fffffff) grid.sync();
        if (PHMASK & 1) ph_prologue(wv, 0, lds, 3, 0, G);
        xcd_barrier(bar);
    }
#define SEAM() xcd_barrier(bar)
#pragma unroll 1
    for (int l = 0; l < 2; ++l) {
        if (l > 0) { if (PHMASK & 1) ph_prologue(wv, l, lds, 2, 0, G); SEAM(); }
        for (int rp_ = 0; rp_ < REP_PH1; ++rp_) { if (PHMASK & 2) ph_prep_h(wv, l, 1, lds); SEAM(); }
        for (int rg_ = 0; rg_ < REP_GIN; ++rg_) { if (rg_ > 0) SEAM();
        if (PHMASK & 4) { const Args a = load_args(); pg8::Gemm g{(const bf16_t*)(a.ws + WS_H), (const bf16_t*)(a.ws + WS_WIN), MTOK, 3840, 1024}; pg8::StaticOrder S; S.init(MTOK, 3840, G, opq_bid());
            pg8::EpiIn E{(bf16_t*)(a.ws + WS_CB), (bf16_t*)(a.ws + WS_P), (bf16_t*)(a.ws + WS_ZQ), (bf16_t*)(a.ws + WS_ZG), (float*)(a.ws + WS_BA)};
            pg8::gemm_phase<pg8::EpiIn, pg8::StaticOrder, true, true>(lds, g, S, E, opq_tid(wv)); } }
        SEAM();
        for (int rp_ = 0; rp_ < REP_CV; ++rp_) { if (PHMASK & 8) ph_conv_prep(wv, l); SEAM(); }
        for (int rp_ = 0; rp_ < REP_PRE; ++rp_) { if (PHMASK & 16) ph_pre(wv, l, lds); SEAM(); }
        for (int rp_ = 0; rp_ < REP_SCAN; ++rp_) { if (PHMASK & 32) ph_scan(wv, l, lds); SEAM(); }
        for (int rp_ = 0; rp_ < REP_MX; ++rp_) { if (PHMASK & 64) ph_mix_prep(wv, l); SEAM(); }
        if (PHMASK & 128) { const Args a = load_args(); const float* MOD = (const float*)(a.ws + WS_MOD); pg8::Gemm g{(const bf16_t*)(a.ws + WS_H), (const bf16_t*)(a.ws + WS_WOUT), MTOK, 1024, 1024}; pg8::StaticOrder S; S.init(MTOK, 1024, G, opq_bid());
            pg8::EpiRes E{l == 0 ? a.x_prompt : a.out, l == 0 ? a.x_sample : a.out + (size_t)4096 * 1024, a.out, MOD + (size_t)l * 9 * 6144 + 2048, 0};
            pg8::gemm_phase<pg8::EpiRes, pg8::StaticOrder, true, true>(lds, g, S, E, opq_tid(wv)); }
        SEAM();
        for (int rp_ = 0; rp_ < REP_PH2; ++rp_) { if (PHMASK & 256) ph_prep_h(wv, l, 2, lds); SEAM(); }
#pragma unroll 1
        for (int half = 0; half < 2; ++half) {
            if (PHMASK & 512) { const Args a = load_args(); pg8::Gemm g{(const bf16_t*)(a.ws + WS_H) + (size_t)half * 10240 * 1024, (const bf16_t*)(a.ws + WS_WUP), 10240, 5632, 1024}; pg8::FlexOrder S; S.init(10240, 5632, G, opq_bid(), (half == 1 && G == 256) ? 160 : 0, 3);
                pg8::EpiUp E{(bf16_t*)(a.ws + WS_UP), 5632};
                pg8::gemm_phase<pg8::EpiUp, pg8::FlexOrder, true, true>(lds, g, S, E, opq_tid(wv)); }
            SEAM();
            for (int rp_ = 0; rp_ < REP_ACT; ++rp_) { if (PHMASK & 1024) ph_act(wv, l, half); SEAM(); }
            for (int rp_ = 0; rp_ < REP_SYNC; ++rp_) SEAM();
            if (PHMASK & 2048) { const Args a = load_args(); const float* MOD = (const float*)(a.ws + WS_MOD); pg8::Gemm g{(const bf16_t*)(a.ws + WS_ACT), (const bf16_t*)(a.ws + WS_WDN), 10240, 1024, 2816}; pg8::StaticOrder S; S.init(10240, 1024, G, opq_bid());
                pg8::EpiRes E{a.out, a.out + (size_t)4096 * 1024, a.out, MOD + (size_t)l * 9 * 6144 + 5120, half * 10240};
                pg8::gemm_phase<pg8::EpiRes, pg8::StaticOrder, true, true>(lds, g, S, E, opq_tid(wv)); }
            if (half == 1 && l == 1) SEAM();
        }
    }
    if (PHMASK & 4096) ph_final(wv);
}

extern "C" void kernel_launch(void* const* d_in, const int* in_sizes, int n_in, void* d_out, int out_size, void* d_ws, size_t ws_size, hipStream_t stream) {
    static int grid = 0;
    if (grid == 0) {
        int dev = 0, cus = 0;
        if (hipGetDevice(&dev) != hipSuccess || hipDeviceGetAttribute(&cus, hipDeviceAttributeMultiprocessorCount, dev) != hipSuccess) { fprintf(stderr, "kernel_launch: device query failed\n"); grid = -1; return; }
        if (hipFuncSetAttribute((const void*)mega_fwd, hipFuncAttributeMaxDynamicSharedMemorySize, LDS_BYTES) != hipSuccess) { fprintf(stderr, "kernel_launch: hipFuncSetAttribute failed\n"); grid = -1; return; }
        int per_cu = 0;
        if (hipOccupancyMaxActiveBlocksPerMultiprocessor(&per_cu, (const void*)mega_fwd, 512, LDS_BYTES) != hipSuccess || per_cu < 1) fprintf(stderr, "kernel_launch: occupancy query says %d blocks/CU\n", per_cu);
        (void)hipGetLastError();
        grid = cus;
        if (n_in != 20 || ws_size < (size_t)250 * MiB) { fprintf(stderr, "kernel_launch: unexpected n_in %d / ws_size %zu\n", n_in, ws_size); }
    }
    if (grid < 0) return;
    Args a{};
    const float** pa = (const float**)&a;
    for (int i = 0; i < 20; ++i) pa[i] = (const float*)d_in[i];
    a.out = (float*)d_out; a.ws = (unsigned char*)d_ws;
    (void)hipMemsetAsync((unsigned char*)d_ws + WS_BAR, 0, (size_t)XCD_BAR_WORDS * 4, stream);
    void* args[] = {&a};
    hipError_t e = hipLaunchCooperativeKernel((const void*)mega_fwd, dim3(grid), dim3(512), args, LDS_BYTES, stream);
    if (e != hipSuccess) fprintf(stderr, "cooperative launch failed: %s (grid %d)\n", hipGetErrorString(e), grid);
}
```

```cpp
#include <hip/hip_runtime.h>
#include <hip/hip_cooperative_groups.h>
#include <cstdio>
#include <cstdint>
namespace cg = cooperative_groups;
namespace pg8 {
#define PG8_LAS __attribute__((address_space(3)))
typedef unsigned short bf16_t;
typedef short bf16x8 __attribute__((ext_vector_type(8)));
typedef float f32x4 __attribute__((ext_vector_type(4)));
typedef unsigned u32x4 __attribute__((ext_vector_type(4)));
constexpr int BM = 256, BK = 64, HALF = 128, HTB = HALF * BK * 2  , STAGE_BYTES = 8 * HTB, NXCD = 8, WGM = 8;

__host__ __device__ __forceinline__ int lds_byte(int r, int c) { const int st = (r >> 4) * 2 + (c >> 5), rr = r & 15, cc = c & 31, ob = rr * 64 + cc * 2; return st * 1024 + (ob ^ (((ob >> 9) & 1) << 5)); }
__host__ __device__ __forceinline__ void stage_rc(int b, int& R, int& C) { const int st = b / 1024, sb = b % 1024, swz = sb ^ (((sb >> 9) & 1) << 5); R = (st >> 1) * 16 + swz / 64; C = (st & 1) * 32 + (swz % 64) / 2; }
__host__ __device__ __forceinline__ int perm32(int rho) { const int n = rho >> 4, i = rho & 15; return 8 * (i >> 2) + 4 * n + (i & 3); }

struct Unit { int pm, pn; };
struct Gemm { const bf16_t* A; const bf16_t* Bt; int M, N, K; };

struct StaticOrder {
    int nM, nN, nwg, G, c;
    __host__ __device__ void init(int M, int N, int G_, int c_) { nM = M / BM; nN = N / BM; nwg = nM * nN; G = G_; c = c_; }
    __host__ __device__ bool next(int i, Unit& u) const {
        const long L = (long)i * G + c; if (L >= nwg) return false;
        int wgid = (int)L; { const int q = nwg / NXCD, r = nwg % NXCD, xcd = wgid % NXCD, off = wgid / NXCD; wgid = (xcd < r ? xcd * (q + 1) : r * (q + 1) + (xcd - r) * q) + off; }
        const int nig = WGM * nN, gid = wgid / nig, fm = gid * WGM, gsz = (nM - fm) < WGM ? (nM - fm) : WGM;
        u.pm = fm + ((wgid % nig) % gsz); u.pn = (wgid % nig) / gsz; return true;
    }
    __device__ __forceinline__ void a_ready(const Unit&) const {}
    __device__ __forceinline__ void done(const Unit&) const {}
};
struct FlexOrder {
    int nM, nN, nwg, G, c, nb, qb;
    __host__ __device__ void init(int M, int N, int G_, int c_, int nb_, int qb_) { nM = M / BM; nN = N / BM; nwg = nM * nN; G = G_; c = c_; nb = nb_; qb = qb_; }
    __host__ __device__ bool next(int i, Unit& u) const {
        long L;
        if (c < nb) { if (i >= qb) return false; L = (long)c + (long)nb * i; } else L = (long)nb * qb + (c - nb) + (long)(G - nb) * i;
        if (L >= nwg) return false;
        int wgid = (int)L; { const int q = nwg / NXCD, r = nwg % NXCD, xcd = wgid % NXCD, off = wgid / NXCD; wgid = (xcd < r ? xcd * (q + 1) : r * (q + 1) + (xcd - r) * q) + off; }
        const int nig = WGM * nN, gid = wgid / nig, fm = gid * WGM, gsz = (nM - fm) < WGM ? (nM - fm) : WGM;
        u.pm = fm + ((wgid % nig) % gsz); u.pn = (wgid % nig) / gsz; return true;
    }
    __device__ __forceinline__ void a_ready(const Unit&) const {}
    __device__ __forceinline__ void done(const Unit&) const {}
};

typedef __bf16 bf16v2_t __attribute__((ext_vector_type(2))); typedef float f32v2_t __attribute__((ext_vector_type(2)));
__device__ __forceinline__ unsigned cvt_pk_bf16(float lo, float hi) { const f32v2_t v = {lo, hi}; const bf16v2_t b = __builtin_convertvector(v, bf16v2_t); return __builtin_bit_cast(unsigned, b); }
typedef unsigned u32x4 __attribute__((ext_vector_type(4)));
struct EpiIn {
    static constexpr bool PERM = true, AFTER_DRAIN = false;
    bf16_t *CB, *P, *ZQ, *ZG; float* BA;
    __device__ __forceinline__ void operator()(const f32x4 (&acc)[2][2][4][2], const Unit& u, int wr, int wc, int fr, int fq) const {
        const int row0 = u.pm * BM + wr * 64 + fr; const int pn = u.pn; const int cl = wc * 32 + 8 * fq;
        if (pn == 14) {
            if (wc == 0 && fq < 2) {
#pragma unroll
                for (int ai = 0; ai < 2; ++ai)
#pragma unroll
                    for (int m = 0; m < 4; ++m) { float* rp = BA + (size_t)(row0 + ai * HALF + m * 16) * 16 + 8 * fq;
                        *(f32x4*)rp = acc[ai][0][m][0]; *(f32x4*)(rp + 4) = acc[ai][0][m][1]; } }
        } else if (pn >= 2 && pn < 6) {
#pragma unroll
            for (int ai = 0; ai < 2; ++ai)
#pragma unroll
                for (int m = 0; m < 4; ++m) { bf16_t* rowp = P + (size_t)(row0 + ai * HALF + m * 16) * 512 + (pn - 2) * 128 + cl;
                    const f32x4 v0 = acc[ai][0][m][0] * acc[ai][1][m][0], v1 = acc[ai][0][m][1] * acc[ai][1][m][1];
                    u32x4 w; w.x = cvt_pk_bf16(v0[0], v0[1]); w.y = cvt_pk_bf16(v0[2], v0[3]); w.z = cvt_pk_bf16(v1[0], v1[1]); w.w = cvt_pk_bf16(v1[2], v1[3]);
                    *(u32x4*)rowp = w; }
        } else {
            bf16_t* base; int ldc, c0;
            if (pn < 2) { base = CB; ldc = 512; c0 = pn * 256; } else if (pn < 12) { base = ZQ; ldc = 1536; c0 = (pn - 6) * 256; } else { base = ZG; ldc = 512; c0 = (pn - 12) * 256; }
#pragma unroll
            for (int ai = 0; ai < 2; ++ai)
#pragma unroll
                for (int m = 0; m < 4; ++m) { bf16_t* rowp = base + (size_t)(row0 + ai * HALF + m * 16) * ldc + c0 + cl;
#pragma unroll
                    for (int bj = 0; bj < 2; ++bj) { const f32x4 v0 = acc[ai][bj][m][0], v1 = acc[ai][bj][m][1];
                        u32x4 w; w.x = cvt_pk_bf16(v0[0], v0[1]); w.y = cvt_pk_bf16(v0[2], v0[3]); w.z = cvt_pk_bf16(v1[0], v1[1]); w.w = cvt_pk_bf16(v1[2], v1[3]);
                        *(u32x4*)(rowp + bj * HALF) = w; } }
        }
    }
};
struct EpiUp {
    static constexpr bool PERM = true, AFTER_DRAIN = false;
    bf16_t* O; int ldc;
    __device__ __forceinline__ void operator()(const f32x4 (&acc)[2][2][4][2], const Unit& u, int wr, int wc, int fr, int fq) const {
        const int row0 = u.pm * BM + wr * 64 + fr; const int col0 = u.pn * BM + wc * 32 + 8 * fq;
        size_t cofs[2];
#pragma unroll
        for (int bj = 0; bj < 2; ++bj) { const int col = col0 + bj * HALF; const int isgt = col >= 2816 ? 1 : 0; const int cg = (col - isgt * 2816) >> 3; const int blk = cg / 44, w = cg - blk * 44;
            cofs[bj] = (size_t)blk * ((size_t)10240 * 704) + (size_t)(isgt * 352 + w * 8); }
#pragma unroll
        for (int ai = 0; ai < 2; ++ai)
#pragma unroll
            for (int m = 0; m < 4; ++m) { bf16_t* rowp = O + (size_t)(row0 + ai * HALF + m * 16) * 704;
#pragma unroll
                for (int bj = 0; bj < 2; ++bj) { const f32x4 v0 = acc[ai][bj][m][0], v1 = acc[ai][bj][m][1];
                    u32x4 w; w.x = cvt_pk_bf16(v0[0], v0[1]); w.y = cvt_pk_bf16(v0[2], v0[3]); w.z = cvt_pk_bf16(v1[0], v1[1]); w.w = cvt_pk_bf16(v1[2], v1[3]);
                    *(u32x4*)(rowp + cofs[bj]) = w; } }
    }
};
struct EpiRes {
    static constexpr bool PERM = false, AFTER_DRAIN = false;
    const float* base_ctx; const float* base_lat; float* out; const float* gate; int row_base;
    __device__ __forceinline__ void operator()(const f32x4 (&acc)[2][2][4][2], const Unit& u, int wr, int wc, int fr, int fq) const {
        const int grow0 = row_base + u.pm * BM;
        const int mi = grow0 < 4096 ? 0 : 1 + ((grow0 - 4096) >> 11);
        const float* g = gate + (size_t)mi * 6144;
        const float* bsrc = grow0 < 4096 ? base_ctx + (size_t)grow0 * 1024 : base_lat + (size_t)(grow0 - 4096) * 1024;
        float* o = out + (size_t)grow0 * 1024;
        const int col0 = u.pn * BM + wc * 32 + 4 * fq;
#pragma unroll
        for (int bj = 0; bj < 2; ++bj)
#pragma unroll
            for (int n = 0; n < 2; ++n) { const f32x4 gv = *(const f32x4*)(g + col0 + bj * HALF + n * 16);
#pragma unroll
                for (int ai = 0; ai < 2; ++ai) {
#pragma unroll
                    for (int m = 0; m < 4; ++m) { const size_t off = (size_t)(ai * HALF + wr * 64 + m * 16 + fr) * 1024 + col0 + bj * HALF + n * 16;
                        const f32x4 bs = *(const f32x4*)(bsrc + off); *(f32x4*)(o + off) = bs + gv * acc[ai][bj][m][n]; }
                    asm volatile("" ::: "memory"); } }
    }
};
template <class Epi, class Sched, bool ALIGN_EPI = false, bool SP2 = false>
__device__ __forceinline__ void gemm_phase(PG8_LAS unsigned char* lds, const Gemm g, const Sched& S, const Epi& E, const int tid_in) {
    const int tid = tid_in, wid = __builtin_amdgcn_readfirstlane(tid >> 6), lane = tid & 63, wr = wid >> 2, wc = wid & 3, fr = lane & 15, fq = lane >> 4;
    const int K = g.K, nt = K / BK;
    unsigned voffA[2], voffB[2];
#pragma unroll
    for (int i = 0; i < 2; ++i) { int R, C; stage_rc(tid * 16 + i * 8192, R, C); const int Rb = Epi::PERM ? ((R & ~31) + perm32(R & 31)) : R;
        voffA[i] = (unsigned)(R * K + C) * 2u; voffB[i] = (unsigned)(Rb * K + C) * 2u; }
    const size_t kstep = (size_t)(BK * 2);
    const size_t hstep = (size_t)HALF * K * 2;
    const size_t tstep = 2 * hstep;
    const unsigned ldsw = (unsigned)wid * 1024u;
    const int aoff = lds_byte(wr * 64 + fr, fq * 8), boff = lds_byte(wc * 32 + fr, fq * 8);
#define PG8_SA(b, h) (((b) * 2 + (h)) * HTB)
#define PG8_SB(b, h) ((4 + (b) * 2 + (h)) * HTB)
#define PG8_STAGE(bufoff, gbase, voff) do { _Pragma("unroll") for (int _i = 0; _i < 2; ++_i) \
        __builtin_amdgcn_global_load_lds((const unsigned*)((const char*)(gbase) + (voff)[_i]), (PG8_LAS unsigned*)(lds + (bufoff) + ldsw + _i * 8192), 16, 0, 0); } while (0)
#define PG8_LDA(dst, b, h) do { _Pragma("unroll") for (int m = 0; m < 4; ++m) _Pragma("unroll") for (int k = 0; k < 2; ++k) dst[m][k] = *(const PG8_LAS bf16x8*)(lds + PG8_SA(b, h) + aoff + m * 2048 + k * 1024); } while (0)
#define PG8_LDB(dst, b, h) do { _Pragma("unroll") for (int n = 0; n < 2; ++n) _Pragma("unroll") for (int k = 0; k < 2; ++k) dst[n][k] = *(const PG8_LAS bf16x8*)(lds + PG8_SB(b, h) + boff + n * 2048 + k * 1024); } while (0)
#define PG8_MMA(ai, bj, At, Bt) do { __builtin_amdgcn_s_setprio(1); _Pragma("unroll") for (int m = 0; m < 4; ++m) _Pragma("unroll") for (int n = 0; n < 2; ++n) _Pragma("unroll") for (int k = 0; k < 2; ++k) \
        acc[ai][bj][m][n] = __builtin_amdgcn_mfma_f32_16x16x32_bf16(Bt[n][k], At[m][k], acc[ai][bj][m][n], 0, 0, 0); __builtin_amdgcn_s_setprio(0); } while (0)
#define PG8_WAIT_V(n) asm volatile("s_waitcnt vmcnt(" #n ")" ::: "memory")
#define PG8_WAIT_L(n) asm volatile("s_waitcnt lgkmcnt(" #n ")" ::: "memory")
#define PG8_BAR __builtin_amdgcn_s_barrier()
#define PG8_SCHED __builtin_amdgcn_sched_barrier(0)
    Unit cur, nxt; int ui = 0;
    if (!S.next(0, cur)) return;
    f32x4 acc[2][2][4][2];
#pragma unroll
    for (int a = 0; a < 2; ++a)
#pragma unroll
        for (int b = 0; b < 2; ++b)
#pragma unroll
            for (int m = 0; m < 4; ++m)
#pragma unroll
                for (int n = 0; n < 2; ++n) acc[a][b][m][n] = (f32x4){0.f, 0.f, 0.f, 0.f};
    bf16x8 At[4][2], B0[2][2], B1[2][2];
    const char* cA = (const char*)g.A + (size_t)cur.pm * tstep; const char* cB = (const char*)g.Bt + (size_t)cur.pn * tstep;
    S.a_ready(cur);
    if constexpr (SP2) {
        PG8_STAGE(PG8_SB(0, 0), cB, voffB); PG8_STAGE(PG8_SB(0, 1), cB + hstep, voffB); PG8_STAGE(PG8_SA(0, 0), cA, voffA); PG8_STAGE(PG8_SA(0, 1), cA + hstep, voffA);
        if (wr == 1) PG8_BAR;
        PG8_WAIT_V(2); PG8_BAR;
        PG8_STAGE(PG8_SB(1, 0), cB + kstep, voffB); PG8_STAGE(PG8_SA(1, 0), cA + kstep, voffA); PG8_STAGE(PG8_SB(1, 1), cB + hstep + kstep, voffB);
        PG8_WAIT_V(6); PG8_BAR;
    } else {
        PG8_STAGE(PG8_SB(0, 0), cB, voffB); PG8_STAGE(PG8_SA(0, 0), cA, voffA); PG8_STAGE(PG8_SB(0, 1), cB + hstep, voffB); PG8_STAGE(PG8_SA(0, 1), cA + hstep, voffA);
        if (wr == 1) PG8_BAR;
        PG8_WAIT_V(4); PG8_BAR;
        PG8_STAGE(PG8_SB(1, 0), cB + kstep, voffB); PG8_STAGE(PG8_SA(1, 0), cA + kstep, voffA); PG8_STAGE(PG8_SB(1, 1), cB + hstep + kstep, voffB);
        PG8_WAIT_V(6); PG8_BAR;
    }
    for (;;) {
        const bool has_next = S.next(ui + 1, nxt);
        const char* nA = has_next ? (const char*)g.A + (size_t)nxt.pm * tstep : cA; const char* nB = has_next ? (const char*)g.Bt + (size_t)nxt.pn * tstep : cB;
        for (int t = 0; t < nt; t += 2) {
            const bool last = (t == nt - 2);
            const char* a1 = cA + (size_t)(t + 1) * kstep;
            const char* a2 = last ? nA : cA + (size_t)(t + 2) * kstep; const char* b2 = last ? nB : cB + (size_t)(t + 2) * kstep;
            const char* a3 = a2 + kstep; const char* b3 = b2 + kstep;
            if (last && has_next) S.a_ready(nxt);
            if constexpr (SP2) {
            PG8_LDB(B0, 0, 0); PG8_LDB(B1, 0, 1); PG8_SCHED; PG8_LDA(At, 0, 0); PG8_STAGE(PG8_SA(1, 1), a1 + hstep, voffA);
            PG8_WAIT_V(8); PG8_WAIT_L(0); PG8_BAR; PG8_MMA(0, 0, At, B0); PG8_MMA(0, 1, At, B1); PG8_BAR; PG8_SCHED;
            PG8_LDA(At, 0, 1); PG8_STAGE(PG8_SB(0, 0), b2, voffB); PG8_STAGE(PG8_SB(0, 1), b2 + hstep, voffB); PG8_STAGE(PG8_SA(0, 0), a2, voffA);
            PG8_WAIT_V(8); PG8_WAIT_L(0); PG8_BAR; PG8_MMA(1, 0, At, B0); PG8_MMA(1, 1, At, B1); PG8_BAR; PG8_SCHED;
            PG8_LDB(B0, 1, 0); PG8_LDB(B1, 1, 1); PG8_SCHED; PG8_LDA(At, 1, 0); PG8_STAGE(PG8_SA(0, 1), a2 + hstep, voffA);
            PG8_WAIT_V(8); PG8_WAIT_L(0); PG8_BAR; PG8_MMA(0, 0, At, B0); PG8_MMA(0, 1, At, B1); PG8_BAR; PG8_SCHED;
            PG8_LDA(At, 1, 1); PG8_STAGE(PG8_SB(1, 0), b3, voffB); PG8_STAGE(PG8_SB(1, 1), b3 + hstep, voffB); PG8_STAGE(PG8_SA(1, 0), a3, voffA);
            PG8_WAIT_V(8); PG8_WAIT_L(0); PG8_BAR; PG8_MMA(1, 0, At, B0); PG8_MMA(1, 1, At, B1); PG8_BAR; PG8_SCHED;
            } else {
            PG8_LDB(B0, 0, 0); PG8_SCHED; PG8_LDA(At, 0, 0); PG8_STAGE(PG8_SA(1, 1), a1 + hstep, voffA);
            PG8_WAIT_L(8); PG8_BAR; PG8_WAIT_L(0); PG8_MMA(0, 0, At, B0); PG8_BAR; PG8_SCHED;
            PG8_LDB(B1, 0, 1); PG8_STAGE(PG8_SB(0, 0), b2, voffB);
            PG8_BAR; PG8_WAIT_L(0); PG8_MMA(0, 1, At, B1); PG8_BAR;
            PG8_LDA(At, 0, 1); PG8_STAGE(PG8_SA(0, 0), a2, voffA);
            PG8_BAR; PG8_WAIT_L(0); PG8_MMA(1, 0, At, B0); PG8_BAR; PG8_SCHED;
            PG8_STAGE(PG8_SB(0, 1), b2 + hstep, voffB);
            PG8_WAIT_V(6); PG8_BAR; PG8_MMA(1, 1, At, B1); PG8_BAR;
            PG8_LDB(B0, 1, 0); PG8_SCHED; PG8_LDA(At, 1, 0); PG8_STAGE(PG8_SA(0, 1), a2 + hstep, voffA);
            PG8_WAIT_L(8); PG8_BAR; PG8_WAIT_L(0); PG8_MMA(0, 0, At, B0); PG8_BAR; PG8_SCHED;
            PG8_LDB(B1, 1, 1); PG8_STAGE(PG8_SB(1, 0), b3, voffB);
            PG8_BAR; PG8_WAIT_L(0); PG8_MMA(0, 1, At, B1); PG8_BAR;
            PG8_LDA(At, 1, 1); PG8_STAGE(PG8_SA(1, 0), a3, voffA);
            PG8_BAR; PG8_WAIT_L(0); PG8_MMA(1, 0, At, B0); PG8_BAR; PG8_SCHED;
            PG8_STAGE(PG8_SB(1, 1), b3 + hstep, voffB);
            PG8_WAIT_V(6); PG8_BAR; PG8_MMA(1, 1, At, B1); PG8_BAR;
            }
        }
        if constexpr (ALIGN_EPI) { if (wr == 0) PG8_BAR; }
        if constexpr (!Epi::AFTER_DRAIN) { E(acc, cur, wr, wc, fr, fq); S.done(cur); }
        if (!has_next) break;
#pragma unroll
        for (int a = 0; a < 2; ++a)
#pragma unroll
            for (int b = 0; b < 2; ++b)
#pragma unroll
                for (int m = 0; m < 4; ++m)
#pragma unroll
                    for (int n = 0; n < 2; ++n) acc[a][b][m][n] = (f32x4){0.f, 0.f, 0.f, 0.f};
        cur = nxt; cA = nA; cB = nB; ++ui;
        if constexpr (ALIGN_EPI) { if (wr == 1) PG8_BAR; }
    }
    PG8_WAIT_V(0);
    if constexpr (!ALIGN_EPI) { if (wr == 0) PG8_BAR; }
    PG8_BAR;
    if constexpr (Epi::AFTER_DRAIN) { E.fused(acc, cur, wr, wc, fr, fq, lds, wid, lane); S.done(cur); }
#undef PG8_SA
#undef PG8_SB
#undef PG8_STAGE
#undef PG8_LDA
#undef PG8_LDB
#undef PG8_MMA
#undef PG8_WAIT_V
#undef PG8_WAIT_L
#undef PG8_BAR
#undef PG8_SCHED
}
}

#define LAS __attribute__((address_space(3)))
using pg8::bf16_t; using pg8::bf16x8; using pg8::f32x4; using pg8::u32x4;
typedef float f32x16 __attribute__((ext_vector_type(16)));
typedef unsigned u32x2 __attribute__((ext_vector_type(2)));

#define REP_PRE 1
#define REP_SCAN 1
#define REP_ACT 1
#define REP_SYNC 0
#define REP_EW 1
#define REP_GIN 1
#define REP_INV 1
#define REP_BLD 1
#define REP_PH1 1
#define REP_CV 1
#define REP_MX 1
#define REP_PH2 1
#ifndef PHMASK
#define PHMASK 0xFFFF
#endif
constexpr int MTOK = 20480;
constexpr float EPS = 1e-6f;
constexpr size_t MiB = (size_t)1 << 20;
constexpr int LDS_BYTES = 147456;
constexpr size_t WS_MOD = 0;
constexpr size_t WS_BAR = 448 * 1024;
constexpr size_t WS_WINX = 512 * 1024;
constexpr size_t WS_WIN = 1 * MiB;
constexpr size_t WS_WOUT = 8 * MiB + 512 * 1024;
constexpr size_t WS_WUP = 10 * MiB + 512 * 1024;
constexpr size_t WS_WDN = 21 * MiB + 512 * 1024;
constexpr size_t WS_BA = 27 * MiB;
constexpr size_t WS_GC = 28 * MiB + 512 * 1024;
constexpr size_t WS_BT = 29 * MiB + 256 * 1024;
constexpr size_t WS_S = 30 * MiB;
constexpr size_t WS_H = WS_S;
constexpr size_t WS_ZG = WS_S + 40 * MiB;
constexpr size_t WS_QKVN = WS_S + 60 * MiB;
constexpr size_t WS_CB = WS_S + 120 * MiB;
constexpr size_t WS_P = WS_S + 140 * MiB;
constexpr size_t WS_ZQ = WS_S + 160 * MiB;
constexpr size_t WS_TQK = WS_ZQ;
constexpr size_t WS_OF = WS_ZQ + 40 * MiB;
constexpr size_t WS_OB = WS_CB;
constexpr size_t WS_UP = WS_S + 40 * MiB;
constexpr size_t WS_ACT = WS_S + 150 * MiB;

struct Args {
    const float *x_prompt, *x_sample, *state, *c, *c_ctx, *w_ada, *b_ada, *norm1_w, *w_in, *conv_a_w, *qkv_conv_w, *a_log, *dt_bias, *o_norm_w, *w_out, *norm2_w, *w_up,
        *ffn_conv_w, *w_down, *final_norm_w;
    float* out; unsigned char* ws;
};
__device__ __forceinline__ unsigned opq_lane() { unsigned z = 0u; asm volatile("" : "+v"(z)); return __builtin_amdgcn_mbcnt_hi(~0u, __builtin_amdgcn_mbcnt_lo(~0u, z)); }
#define CAS __attribute__((address_space(4)))
#define GAS __attribute__((address_space(1)))
__device__ __forceinline__ Args load_args() {
    Args r{};
#if defined(__HIP_DEVICE_COMPILE__)
    const CAS unsigned long long* ap = (const CAS unsigned long long*)__builtin_amdgcn_kernarg_segment_ptr(); asm volatile("" : "+s"(ap));
    const float** rp = (const float**)&r;
#pragma unroll
    for (int i = 0; i < 20; ++i) rp[i] = (const float*)(const GAS float*)ap[i];
    r.out = (float*)(GAS float*)ap[20]; r.ws = (unsigned char*)(GAS unsigned char*)ap[21];
#endif
    return r;
}

__device__ __forceinline__ float bflo(unsigned w) { return __builtin_bit_cast(float, w << 16); }
__device__ __forceinline__ float bfhi(unsigned w) { return __builtin_bit_cast(float, w & 0xffff0000u); }
__device__ __forceinline__ float bf2f(bf16_t b) { return __builtin_bit_cast(float, (unsigned)b << 16); }
__device__ __forceinline__ unsigned pk(float lo, float hi) { return pg8::cvt_pk_bf16(lo, hi); }
__device__ __forceinline__ bf16_t f2bf(float f) { return (bf16_t)(pk(f, 0.f) & 0xffffu); }
__device__ __forceinline__ float shx(const float v, const int o, const int lane) { return __builtin_bit_cast(float, __builtin_amdgcn_ds_bpermute((lane ^ o) << 2, __builtin_bit_cast(int, v))); }
__device__ __forceinline__ float wave_sum(float v) {
#pragma unroll
    for (int o = 1; o < 64; o <<= 1) v += __shfl_xor(v, o);
    return v;
}
__device__ __forceinline__ float silu_f(float x) { return x / (1.f + __expf(-x)); }
__device__ __forceinline__ void unpack8(const u32x4 w, float (&f)[8]) {
    f[0] = bflo(w.x); f[1] = bfhi(w.x); f[2] = bflo(w.y); f[3] = bfhi(w.y); f[4] = bflo(w.z); f[5] = bfhi(w.z); f[6] = bflo(w.w); f[7] = bfhi(w.w);
}
__device__ __forceinline__ u32x4 pack8(const float (&f)[8]) { u32x4 w; w.x = pk(f[0], f[1]); w.y = pk(f[2], f[3]); w.z = pk(f[4], f[5]); w.w = pk(f[6], f[7]); return w; }
__device__ __forceinline__ void load8f(const float* p, float (&f)[8]) { const f32x4 a = *(const f32x4*)p, b = *(const f32x4*)(p + 4); f[0] = a.x; f[1] = a.y; f[2] = a.z; f[3] = a.w; f[4] = b.x; f[5] = b.y; f[6] = b.z; f[7] = b.w; }
__device__ __forceinline__ int opq_tid(const int wv) { int t = wv * 64 + (int)opq_lane(); asm volatile("" : "+v"(t)); return t; }
__device__ __forceinline__ int opq_bid() { int b = blockIdx.x; asm volatile("" : "+s"(b)); return b; }
#define MFMA32(a, b, c) __builtin_amdgcn_mfma_f32_32x32x16_bf16((a), (b), (c), 0, 0, 0)
#define LDS_WAIT() asm volatile("s_waitcnt lgkmcnt(0)" ::: "memory")

#define XB_TMO      128
#define XB_XCNT(j)  (256  + 64 * (j))
#define XB_XSUB(j)  (1280 + 64 * (j))
#define XB_XGEN(j)  (2304 + 64 * (j))
#define XB_TOP      3328
#define XB_TOPGEN   3392
#define XCD_BAR_WORDS 3456
#define XB_SPIN_CAP (1u << 18)

__device__ __forceinline__ unsigned xb_ld(unsigned* p)              { return __hip_atomic_load(p, __ATOMIC_RELAXED, __HIP_MEMORY_SCOPE_AGENT); }
__device__ __forceinline__ unsigned xb_add(unsigned* p, unsigned v) { return __hip_atomic_fetch_add(p, v, __ATOMIC_RELAXED, __HIP_MEMORY_SCOPE_AGENT); }
__device__ __forceinline__ unsigned xb_xcc_id() { return (unsigned)__builtin_amdgcn_s_getreg((3 << 11) | 20) & 0xFu; }
#define XB_SPIN(cond, bar) do { unsigned _sp = 0; while (cond) { __builtin_amdgcn_s_sleep(1); \
    if ((++_sp & 255u) == 0u) { if (xb_ld(&(bar)[XB_TMO])) break; if (_sp > XB_SPIN_CAP) { atomicAdd(&(bar)[XB_TMO], 1u); break; } } } } while (0)

struct XcdBarrier {
    int wv; unsigned* bar; unsigned x;
    volatile LAS unsigned* st;
};

__device__ __forceinline__ XcdBarrier xcd_barrier_post(unsigned* bar, volatile LAS unsigned* st, const int wv0) {
    XcdBarrier b; b.bar = bar; b.x = xb_xcc_id(); b.st = st; b.wv = wv0;
    if (wv0 == 0 && opq_lane() == 0u) (void)xb_add(&bar[XB_XCNT(b.x)], 1u);
    return b;
}
__device__ __forceinline__ void xcd_barrier_complete(unsigned* bar, unsigned x, unsigned& nloc, unsigned& nx) {
    const unsigned G = gridDim.x * gridDim.y * gridDim.z;
    unsigned sum, cnt, mine, sp = 0u;
    for (;;) {
        sum = 0u; cnt = 0u; mine = 0u;
#pragma unroll
        for (unsigned j = 0; j < 16; ++j) { const unsigned c = xb_ld(&bar[XB_XCNT(j)]); sum += c; cnt += (c > 0u) ? 1u : 0u; mine = (j == x) ? c : mine; }
        if (sum == G) break;
        __builtin_amdgcn_s_sleep(1);
        if ((++sp & 255u) == 0u) { if (xb_ld(&bar[XB_TMO])) break; if (sp > XB_SPIN_CAP) { atomicAdd(&bar[XB_TMO], 1u); break; } }
    }
    nloc = mine > 0u ? mine : 1u; nx = cnt > 0u ? cnt : 1u;
}

__device__ __forceinline__ void xcd_barrier(const XcdBarrier& b) {
    asm volatile("s_waitcnt vmcnt(0)" ::: "memory");
    __syncthreads();
    if (b.wv == 0 && opq_lane() == 0u) {
        unsigned* bar = b.bar;
        __builtin_amdgcn_s_waitcnt(0);
        unsigned nloc = b.st[0], nx = b.st[1];
        if (nloc == 0u) { xcd_barrier_complete(bar, b.x, nloc, nx); b.st[0] = nloc; b.st[1] = nx; }
        const unsigned old = xb_add(&bar[XB_XSUB(b.x)], 1u);
        const unsigned gen = old / nloc;
        if (old + 1u == (gen + 1u) * nloc) {
            __builtin_amdgcn_fence(__ATOMIC_RELEASE, "agent");
            asm volatile("s_waitcnt vmcnt(0)" ::: "memory");
            const unsigned og = xb_add(&bar[XB_TOP], 1u);
            const unsigned tg = og / nx;
            if (og + 1u == (tg + 1u) * nx) xb_add(&bar[XB_TOPGEN], 1u);
            else XB_SPIN(xb_ld(&bar[XB_TOPGEN]) == tg, bar);
            __builtin_amdgcn_fence(__ATOMIC_ACQUIRE, "agent");
            xb_add(&bar[XB_XGEN(b.x)], 1u);
            asm volatile("s_waitcnt vmcnt(0)" ::: "memory");
        } else {
            XB_SPIN(xb_ld(&bar[XB_XGEN(b.x)]) == gen, bar);
            __builtin_amdgcn_fence(__ATOMIC_ACQUIRE, "agent");
            asm volatile("s_waitcnt vmcnt(0)" ::: "memory");
        }
    }
    __syncthreads();
}

__device__ __forceinline__ void transpose_item(const float* W, int ldw, int K, bf16_t* WT, int k0, int n0, int dst0, LAS float* scr, int lane, int ncols) {
    const bool colok = n0 + (lane & 31) < ncols;
#pragma unroll
    for (int i = 0; i < 32; ++i) { const int kk = 2 * i + (lane >> 5); scr[kk * 33 + (lane & 31)] = colok ? W[(size_t)(k0 + kk) * ldw + n0 + (lane & 31)] : 0.f; }
    LDS_WAIT();
    const int c = lane & 7;
#pragma unroll
    for (int j = 0; j < 4; ++j) { const int n = (lane >> 3) + 8 * j; const LAS float* s = scr + (8 * c) * 33 + n;
        u32x4 o; o.x = pk(s[0 * 33], s[1 * 33]); o.y = pk(s[2 * 33], s[3 * 33]); o.z = pk(s[4 * 33], s[5 * 33]); o.w = pk(s[6 * 33], s[7 * 33]);
        *(u32x4*)(WT + (size_t)(dst0 + n) * K + k0 + 8 * c) = o; }
    LDS_WAIT();
}
__device__ __forceinline__ void ph_prologue(const int wv, const int l, LAS unsigned char* lds, const int parts, const int b0, const int nb) {
    const Args a = load_args();
    const int tid = opq_tid(wv), lane = tid & 63, wave = __builtin_amdgcn_readfirstlane(tid >> 6); const int bid = opq_bid();
    if ((parts & 1) && bid < 192) {
        LAS float* sc = (LAS float*)(lds + 73728);
        LAS float* red = (LAS float*)(lds + 110592);
        float* MOD = (float*)(a.ws + WS_MOD);
        for (int e = tid; e < 9 * 1024; e += 512) { const int mi = e >> 10, k = e & 1023; const float v = mi == 0 ? a.c_ctx[k] : a.c[(mi - 1) * 1024 + k]; sc[e] = silu_f(v); }
        __syncthreads();
        const int lay = bid / 96, n0 = (bid % 96) * 64;
        const float* W = a.w_ada + (size_t)lay * 1024 * 6144 + n0 + lane;
        float acc[9];
#pragma unroll
        for (int mi = 0; mi < 9; ++mi) acc[mi] = 0.f;
        const int kb = wave * 128;
#pragma unroll 16
        for (int k = 0; k < 128; ++k) { const float wv = W[(size_t)(kb + k) * 6144];
#pragma unroll
            for (int mi = 0; mi < 9; ++mi) acc[mi] += sc[mi * 1024 + kb + k] * wv; }
#pragma unroll
        for (int mi = 0; mi < 9; ++mi) red[(wave * 9 + mi) * 64 + lane] = acc[mi];
        __syncthreads();
        for (int t = tid; t < 576; t += 512) { const int mi = t >> 6, ln = t & 63; float s = a.b_ada[lay * 6144 + n0 + ln];
#pragma unroll
            for (int w = 0; w < 8; ++w) s += red[(w * 9 + mi) * 64 + ln];
            MOD[(size_t)(lay * 9 + mi) * 6144 + n0 + ln] = s; }
        __syncthreads();
    }
    if (parts & 2) { u32x4* z = (u32x4*)((bf16_t*)(a.ws + WS_WIN) + (size_t)3616 * 1024); const u32x4 z4 = {0u, 0u, 0u, 0u};
        for (int i = bid * 512 + tid; i < 224 * 128; i += gridDim.x * 512) z[i] = z4; }
    LAS float* scr = (LAS float*)(lds + wave * 8448);
    const int gw = (bid - b0) * 8 + wave, NGW = nb * 8;
    constexpr int I_IN = 16 * 113, I_OUT = 16 * 32, I_UP = 16 * 176, I_DN = 44 * 32;
    const int it_lo = (parts & 2) ? 0 : I_IN + I_OUT, it_hi = (parts & 4) ? I_IN + I_OUT + I_UP + I_DN : I_IN + I_OUT;
    for (int it = it_lo + gw; it < it_hi; it += NGW) {
        int r = it;
        if (r < I_IN) { const int kb = r / 113, n0 = (r % 113) * 32; int dst;
            if (n0 < 512) dst = n0; else if (n0 < 1024) { const int ch = n0 - 512; dst = 512 + (ch >> 7) * 256 + (ch & 127); }
            else if (n0 < 1536) { const int ch = n0 - 1024; dst = 512 + (ch >> 7) * 256 + 128 + (ch & 127); } else dst = n0;
            transpose_item(a.w_in + (size_t)l * 1024 * 3600, 3600, 1024, (bf16_t*)(a.ws + WS_WIN), kb * 64, n0, dst, scr, lane, 3600); continue; }
        r -= I_IN;
        if (r < I_OUT) { const int kb = r / 32, n0 = (r % 32) * 32; transpose_item(a.w_out + (size_t)l * 1024 * 1024, 1024, 1024, (bf16_t*)(a.ws + WS_WOUT), kb * 64, n0, n0, scr, lane, 1024); continue; }
        r -= I_OUT;
        if (r < I_UP) { const int kb = r / 176, n0 = (r % 176) * 32; transpose_item(a.w_up + (size_t)l * 1024 * 5632, 5632, 1024, (bf16_t*)(a.ws + WS_WUP), kb * 64, n0, n0, scr, lane, 5632); continue; }
        r -= I_UP;
        { const int kb = r / 32, n0 = (r % 32) * 32; transpose_item(a.w_down + (size_t)l * 2816 * 1024, 1024, 2816, (bf16_t*)(a.ws + WS_WDN), kb * 64, n0, n0, scr, lane, 1024); }
    }
}

__device__ __forceinline__ void ph_prep_h(const int wv, const int l, const int which, LAS unsigned char* lds) {
    const Args a = load_args();
    const int tid = opq_tid(wv), lane = tid & 63, wave = __builtin_amdgcn_readfirstlane(tid >> 6); const int bid = opq_bid();
    const int gw = bid * 8 + wave, NGW = gridDim.x * 8;
    const float* MOD = (const float*)(a.ws + WS_MOD);
    const float* nw = (which == 1 ? a.norm1_w : a.norm2_w) + l * 1024;
    bf16_t* H = (bf16_t*)(a.ws + WS_H);
    const float* WX = (const float*)(a.ws + WS_WINX);
    float* BA = (float*)(a.ws + WS_BA);
    f32x4 nwv[4];
#pragma unroll
    for (int j = 0; j < 4; ++j) nwv[j] = *(const f32x4*)(nw + 4 * (lane + 64 * j));
    for (int rowb = gw; rowb < MTOK; rowb += 2 * NGW) {
        f32x4 v[2][4]; float ss[2] = {0.f, 0.f};
#pragma unroll
        for (int u = 0; u < 2; ++u) { const int row = rowb + u * NGW; if (row < MTOK) { const float* xr;
            if (which == 1 && l == 0) xr = row < 4096 ? a.x_prompt + (size_t)row * 1024 : a.x_sample + (size_t)(row - 4096) * 1024;
            else xr = a.out + (size_t)row * 1024;
#pragma unroll
            for (int j = 0; j < 4; ++j) v[u][j] = *(const f32x4*)(xr + 4 * (lane + 64 * j)); } }
#pragma unroll
        for (int u = 0; u < 2; ++u) { const int row = rowb + u * NGW; if (row < MTOK) {
#pragma unroll
            for (int j = 0; j < 4; ++j) ss[u] += (v[u][j].x * v[u][j].x + v[u][j].y * v[u][j].y) + (v[u][j].z * v[u][j].z + v[u][j].w * v[u][j].w);
            const int mi = row < 4096 ? 0 : 1 + ((row - 4096) >> 11);
            const float* mod = MOD + (size_t)(l * 9 + mi) * 6144 + (which == 1 ? 0 : 3072);
            const float rstd = rsqrtf(wave_sum(ss[u]) * (1.f / 1024.f) + EPS);
#pragma unroll
            for (int j = 0; j < 4; ++j) { const f32x4 sh = *(const f32x4*)(mod + 4 * (lane + 64 * j)), sc = *(const f32x4*)(mod + 1024 + 4 * (lane + 64 * j));
                v[u][j] = v[u][j] * rstd * nwv[j] * (sc + 1.f) + sh;
                u32x2 o; o.x = pk(v[u][j].x, v[u][j].y); o.y = pk(v[u][j].z, v[u][j].w);
                *(u32x2*)(H + (size_t)row * 1024 + 4 * (lane + 64 * j)) = o; }
} }
    }
}

__device__ __forceinline__ void ph_conv_prep(const int wv, const int l) {
    const Args a = load_args();
    const int tid = opq_tid(wv), lane = tid & 63, wave = __builtin_amdgcn_readfirstlane(tid >> 6); const int bid = opq_bid();
    const int gw = bid * 8 + wave, NGW = gridDim.x * 8;
    const bf16_t* CB = (const bf16_t*)(a.ws + WS_CB); const bf16_t* P = (const bf16_t*)(a.ws + WS_P); const bf16_t* ZQ = (const bf16_t*)(a.ws + WS_ZQ);
    bf16_t* A = (bf16_t*)(a.ws + WS_H); bf16_t* QKVN = (bf16_t*)(a.ws + WS_QKVN);
    const float* wa = a.conv_a_w + (size_t)l * 3 * 512; const float* wq = a.qkv_conv_w + (size_t)l * 3 * 1536;
    const u32x4 zero4 = {0u, 0u, 0u, 0u};
    for (int rowb = gw; rowb < MTOK; rowb += 2 * NGW) {
        u32x4 pc[2], pl[2], pr[2], cb[2], zc[2][3], zl[2][3], zr[2][3];
#pragma unroll
        for (int u = 0; u < 2; ++u) { const int row = rowb + u * NGW; if (row < MTOK) {
            int pos, rl; if (row < 4096) { pos = row & 255; rl = 256; } else { pos = (row - 4096) & 63; rl = 64; }
            const bool hasL = pos > 0, hasR = pos < rl - 1;
            const bf16_t* pp = P + (size_t)row * 512 + lane * 8;
            pc[u] = *(const u32x4*)pp; pl[u] = hasL ? *(const u32x4*)(pp - 512) : zero4; pr[u] = hasR ? *(const u32x4*)(pp + 512) : zero4; cb[u] = *(const u32x4*)(CB + (size_t)row * 512 + lane * 8);
#pragma unroll
            for (int seg = 0; seg < 3; ++seg) { const bf16_t* zp = ZQ + (size_t)row * 1536 + seg * 512 + lane * 8;
                zc[u][seg] = *(const u32x4*)zp; zl[u][seg] = hasL ? *(const u32x4*)(zp - 1536) : zero4; zr[u][seg] = hasR ? *(const u32x4*)(zp + 1536) : zero4; } } }
#pragma unroll
        for (int u = 0; u < 2; ++u) { const int row = rowb + u * NGW; if (row < MTOK) {
            { const int c = lane * 8;
                float w0[8], w1[8], w2[8], fl[8], fc[8], fr[8], fb[8], y[8];
                load8f(wa + c, w0); load8f(wa + 512 + c, w1); load8f(wa + 1024 + c, w2);
                unpack8(pl[u], fl); unpack8(pc[u], fc); unpack8(pr[u], fr); unpack8(cb[u], fb);
#pragma unroll
                for (int e = 0; e < 8; ++e) y[e] = fb[e] * (w0[e] * fl[e] + w1[e] * fc[e] + w2[e] * fr[e]);
                *(u32x4*)(A + (size_t)row * 1024 + c) = pack8(y); }
#pragma unroll
            for (int seg = 0; seg < 3; ++seg) { const int c = seg * 512 + lane * 8;
                float w0[8], w1[8], w2[8], fl[8], fc[8], fr[8], x[8];
                load8f(wq + c, w0); load8f(wq + 1536 + c, w1); load8f(wq + 3072 + c, w2);
                unpack8(zl[u][seg], fl); unpack8(zc[u][seg], fc); unpack8(zr[u][seg], fr);
                float ss = 0.f;
#pragma unroll
                for (int e = 0; e < 8; ++e) { x[e] = silu_f(w0[e] * fl[e] + w1[e] * fc[e] + w2[e] * fr[e]); ss += x[e] * x[e]; }
                if (seg < 2) { ss += __shfl_xor(ss, 1); ss += __shfl_xor(ss, 2); ss += __shfl_xor(ss, 4); ss += __shfl_xor(ss, 8);
                    const float sc = rsqrtf(ss + EPS) * (seg == 0 ? 0.08838834764831845f : 1.f);
#pragma unroll
                    for (int e = 0; e < 8; ++e) x[e] *= sc; }
                *(u32x4*)(QKVN + (size_t)row * 1536 + c) = pack8(x); } } }
    }
}

template <int RI, int HF> __device__ __forceinline__ void inv_seg_load(f32x4 (&dst)[8], const LAS float* Lm) {
#pragma unroll
    for (int jj = 0; jj < 8; ++jj) if (HF * 32 + jj * 4 < RI) dst[jj] = *(const LAS f32x4*)(Lm + RI * 64 + HF * 32 + jj * 4);
}
template <int I, int HF> __device__ __forceinline__ void inv_seg(float (&t)[64], f32x4 (&Lr)[2][8], const LAS float* Lm, float& a0, float& a1, float& a2, float& a3, float& last) {
    constexpr int SIDX = (I <= 32) ? I : 32 + 2 * (I - 32) - 1 + HF;
    constexpr int NI = (HF == 0 && I > 32) ? I : I + 1, NH = (HF == 0 && I > 32) ? 1 : 0;
    if constexpr (NI < 64) inv_seg_load<NI, NH>(Lr[(SIDX + 1) & 1], Lm);
    __builtin_amdgcn_sched_barrier(0);
#pragma unroll
    for (int jj = 0; jj < 8; ++jj) { const int j0 = HF * 32 + jj * 4; if (j0 < I) { const f32x4 l4 = Lr[SIDX & 1][jj];
        if (j0 + 0 < I - 1) a0 -= l4.x * t[j0 + 0]; else if (j0 + 0 == I - 1) last = l4.x;
        if (j0 + 1 < I - 1) a1 -= l4.y * t[(j0 + 1) & 63]; else if (j0 + 1 == I - 1) last = l4.y;
        if (j0 + 2 < I - 1) a2 -= l4.z * t[(j0 + 2) & 63]; else if (j0 + 2 == I - 1) last = l4.z;
        if (j0 + 3 < I - 1) a3 -= l4.w * t[(j0 + 3) & 63]; else if (j0 + 3 == I - 1) last = l4.w; } }
    __builtin_amdgcn_sched_barrier(0);
}
template <int I> __device__ __forceinline__ void inv_rows(float (&t)[64], f32x4 (&Lr)[2][8], const LAS float* Lm, bf16_t* To, const int lane) {
    if constexpr (I < 64) {
        float a0 = 0.f, a1 = 0.f, a2 = 0.f, a3 = 0.f, last = 0.f;
        if constexpr (I > 0) inv_seg<I, 0>(t, Lr, Lm, a0, a1, a2, a3, last);
        if constexpr (I > 32) inv_seg<I, 1>(t, Lr, Lm, a0, a1, a2, a3, last);
        float acc = ((I == lane) ? 1.f : 0.f) + ((a0 + a1) + (a2 + a3));
        if constexpr (I > 0) acc -= last * t[I - 1];
        t[I] = acc; To[I * 64] = f2bf(acc);
        inv_rows<I + 1>(t, Lr, Lm, To, lane);
    }
}
__device__ __forceinline__ void ph_pre(const int wv, const int l, LAS unsigned char* lds) {
    const Args a = load_args();
    const int tid = opq_tid(wv), lane = tid & 63, wave = __builtin_amdgcn_readfirstlane(tid >> 6); const int bid = opq_bid();
    const bf16_t* QKVN = (const bf16_t*)(a.ws + WS_QKVN); const float* BA = (const float*)(a.ws + WS_BA);
    float* GC = (float*)(a.ws + WS_GC); float* BT = (float*)(a.ws + WS_BT); bf16_t* TQK = (bf16_t*)(a.ws + WS_TQK);
    const int hb = wave >> 2, w4 = wave & 3, t256 = tid & 255;
    LAS unsigned char* lb = lds + hb * 69632;
    LAS unsigned char* sK = lb; LAS unsigned char* sQ = lb + 17408;
    LAS float* sGram = (LAS float*)(lb + 34816); LAS float* sQK = (LAS float*)(lb + 51456);
    LAS float* sL = (LAS float*)lb;
    LAS float* sG = (LAS float*)(lb + 68096); LAS float* sB = (LAS float*)(lb + 68608);
    for (int it2 = bid; it2 < 640; it2 += gridDim.x) {
        const int it = it2 * 2 + hb;
        const int gc = it >> 2, h = it & 3, r0 = gc * 64;
#pragma unroll
        for (int rep = 0; rep < 4; ++rep) { const int ch = t256 + rep * 256, row = ch >> 4, c16 = ch & 15;
            const bf16_t* src = QKVN + (size_t)(r0 + row) * 1536 + h * 128 + c16 * 8;
            *(LAS u32x4*)(sQ + row * 272 + c16 * 16) = *(const u32x4*)src;
            *(LAS u32x4*)(sK + row * 272 + c16 * 16) = *(const u32x4*)(src + 512); }
        if (w4 < 2) { const int d = w4, i = d ? 63 - lane : lane, row = r0 + i;
            const float bl = BA[(size_t)row * 16 + d * 4 + h], ai = BA[(size_t)row * 16 + 8 + d * 4 + h];
            const float beta = 1.f / (1.f + __expf(-bl));
            const float xx = ai + a.dt_bias[l * 8 + d * 4 + h];
            const float sp = fmaxf(xx, 0.f) + __logf(1.f + __expf(-fabsf(xx)));
            float g = -__expf(a.a_log[l * 8 + d * 4 + h]) * sp;
#pragma unroll
            for (int off = 1; off < 64; off <<= 1) { const float t = __shfl_up(g, off); if (lane >= off) g += t; }
            sG[d * 64 + lane] = g; sB[d * 64 + lane] = beta; GC[(size_t)row * 8 + d * 4 + h] = g; BT[(size_t)row * 8 + d * 4 + h] = beta; }
        __syncthreads();
        f32x16 acc2[2];
#pragma unroll
        for (int k2 = 0; k2 < 2; ++k2) { const int t8 = w4 * 2 + k2, mi = (t8 >> 1) & 1, ni = t8 & 1, r = lane & 31, hh = lane >> 5; const LAS unsigned char* sA = t8 < 4 ? sK : sQ;
#pragma unroll
            for (int i = 0; i < 16; ++i) acc2[k2][i] = 0.f;
#pragma unroll
            for (int kk = 0; kk < 8; ++kk) { const bf16x8 av = *(const LAS bf16x8*)(sA + (mi * 32 + r) * 272 + (kk * 16 + 8 * hh) * 2);
                const bf16x8 bv = *(const LAS bf16x8*)(sK + (ni * 32 + r) * 272 + (kk * 16 + 8 * hh) * 2); acc2[k2] = MFMA32(av, bv, acc2[k2]); } }
#pragma unroll
        for (int k2 = 0; k2 < 2; ++k2) { const int t8 = w4 * 2 + k2, mi = (t8 >> 1) & 1, ni = t8 & 1, r = lane & 31, hh = lane >> 5;
            LAS float* dst = t8 < 4 ? sGram : sQK;
#pragma unroll
            for (int reg = 0; reg < 16; ++reg) { const int i = mi * 32 + (reg & 3) + 8 * (reg >> 2) + 4 * hh, j = ni * 32 + r; dst[i * 65 + j] = acc2[k2][reg]; } }
        __syncthreads();
        for (int e = t256; e < 8192; e += 256) { const int d = e >> 12, p = (e >> 6) & 63, q = e & 63; const int i = d ? 63 - p : p, j = d ? 63 - q : q;
            const float dec = p >= q ? __expf(sG[d * 64 + p] - sG[d * 64 + q]) : 0.f;
            sL[e] = p > q ? sB[d * 64 + p] * sGram[i * 65 + j] * dec : 0.f;
            TQK[(size_t)(it * 2 + d) * 8192 + 4096 + p * 64 + ((q & 32) + 8 * ((q >> 2) & 3) + 4 * ((q >> 4) & 1) + (q & 3))] = f2bf(sQK[i * 65 + j] * dec); }
        __syncthreads();
        if (w4 < 2) { const int d = w4; const LAS float* Lm = sL + d * 4096; bf16_t* To = TQK + (size_t)(it * 2 + d) * 8192 + ((lane & 32) + 8 * ((lane >> 2) & 3) + 4 * ((lane >> 4) & 1) + (lane & 3));
            float t[64]; f32x4 Lr[2][8];
            inv_seg_load<1, 0>(Lr[1], Lm);
            inv_rows<0>(t, Lr, Lm, To, lane);
        }
        __syncthreads();
    }
}

#define MFMA16(a, b, c) __builtin_amdgcn_mfma_f32_16x16x32_bf16((a), (b), (c), 0, 0, 0)
__device__ __forceinline__ bf16x8 pack_b(const f32x4 lo, const f32x4 hi) { u32x4 w; w.x = pk(lo[0], lo[1]); w.y = pk(lo[2], lo[3]); w.z = pk(hi[0], hi[1]); w.w = pk(hi[2], hi[3]); return __builtin_bit_cast(bf16x8, w); }
__device__ __forceinline__ void ph_scan(const int wv, const int l, LAS unsigned char* lds) {
    const Args a = load_args();
    const int tid = opq_tid(wv), lane = tid & 63, wave = __builtin_amdgcn_readfirstlane(tid >> 6); const int bid = opq_bid();
    if (bid >= 256) return;
    int r0, nch, h, d, sidx, ncw, dvbase; bool lat;
    if (bid < 128) { lat = true; const int it = (bid >> 4) * 8 + (bid & 7); sidx = it >> 3; h = (it >> 1) & 3; d = it & 1; r0 = 4096 + sidx * 2048; nch = 32; ncw = 4; dvbase = ((bid >> 3) & 1) * 64; }
    else { lat = false; const int it = bid - 128; sidx = it >> 3; h = (it >> 1) & 3; d = it & 1; r0 = sidx * 256; nch = 4; ncw = 8; dvbase = 0; }
    const bf16_t* QKVN = (const bf16_t*)(a.ws + WS_QKVN); const float* GC = (const float*)(a.ws + WS_GC); const float* BT = (const float*)(a.ws + WS_BT);
    const bf16_t* TQK = (const bf16_t*)(a.ws + WS_TQK); bf16_t* OD = (bf16_t*)(a.ws + (d ? WS_OB : WS_OF));
    constexpr int BUFB = 72464, O_KB = 0, O_QD = 17408, O_KE = 34816, O_T = 53248, O_QK = 62464, O_BT = 71680, O_EG = 71952, O_EK = 72208;
    const bool cw = wave < ncw;
    const int c16 = lane & 15, g = lane >> 4;
    const int dv = dvbase + wave * 16 + c16;
    const bool fillA = lat ? (wave >= 4) : true, fillB = lat && (wave >= 4);
    const int slotA = lat ? tid - 256 : tid, slotB = slotA + 256;
    const int pA = slotA >> 3, partA = slotA & 7, ipA = d ? 63 - pA : pA, pB = slotB >> 3, partB = slotB & 7, ipB = d ? 63 - pB : pB;
    u32x4 pk0A, pk1A, pq0A, pq1A, pTA, pQA, pk0B, pk1B, pq0B, pq1B, pTB, pQB; float pgA, pbetaA, pglastA, pgB, pbetaB, pglastB; bf16_t pv[16]; unsigned osv[8]; unsigned gprev = 0u;
#define LOADG(n, X) do { const int cn_ = d ? nch - 1 - (n) : (n); const unsigned gcn_ = (unsigned)((r0 >> 6) + cn_); const unsigned row_ = gcn_ * 64u + (unsigned)ip##X; \
        const unsigned qo_ = row_ * 1536u + (unsigned)(h * 128 + part##X * 16); pq0##X = *(const u32x4*)(QKVN + qo_); pq1##X = *(const u32x4*)(QKVN + qo_ + 8u); pk0##X = *(const u32x4*)(QKVN + qo_ + 512u); pk1##X = *(const u32x4*)(QKVN + qo_ + 520u); \
        pg##X = GC[row_ * 8u + (unsigned)(d * 4 + h)]; pbeta##X = BT[row_ * 8u + (unsigned)(d * 4 + h)]; pglast##X = GC[(gcn_ * 64u + (d ? 0u : 63u)) * 8u + (unsigned)(d * 4 + h)]; \
        const unsigned to_ = ((gcn_ * 4u + (unsigned)h) * 2u + (unsigned)d) * 8192u + (unsigned)slot##X * 8u; pT##X = *(const u32x4*)(TQK + to_); pQ##X = *(const u32x4*)(TQK + to_ + 4096u); } while (0)
#define LOADV(n) do { const int cn_ = d ? nch - 1 - (n) : (n); const unsigned gcn_ = (unsigned)((r0 >> 6) + cn_); \
        _Pragma("unroll") for (int q_ = 0; q_ < 16; ++q_) { const int pp_ = 16 * (q_ >> 2) + 4 * g + (q_ & 3), ii_ = d ? 63 - pp_ : pp_; \
            pv[q_] = QKVN[(gcn_ * 64u + (unsigned)ii_) * 1536u + (unsigned)(1024 + h * 128 + dv)]; } } while (0)
#define STOREO() do { _Pragma("unroll") for (int q_ = 0; q_ < 16; ++q_) { const int pp_ = 16 * (q_ >> 2) + 4 * g + (q_ & 3), ii_ = d ? 63 - pp_ : pp_; \
            OD[(gprev * 64u + (unsigned)ii_) * 512u + (unsigned)(h * 128 + dv)] = (bf16_t)((q_ & 1) ? (osv[q_ >> 1] >> 16) : (osv[q_ >> 1] & 0xffffu)); } } while (0)
#define FILL(B, X) do { LAS unsigned char* b_ = lds + (B) * BUFB; \
          \
        { const int bo_ = p##X * 272 + (32 * (part##X >> 1) + 4 * (part##X & 1)) * 2; \
            *(LAS u32x2*)(b_ + O_KB + bo_) = (u32x2){pk0##X.x, pk0##X.y}; *(LAS u32x2*)(b_ + O_KB + bo_ + 16) = (u32x2){pk0##X.z, pk0##X.w}; \
            *(LAS u32x2*)(b_ + O_KB + bo_ + 32) = (u32x2){pk1##X.x, pk1##X.y}; *(LAS u32x2*)(b_ + O_KB + bo_ + 48) = (u32x2){pk1##X.z, pk1##X.w}; \
            *(LAS u32x2*)(b_ + O_QD + bo_) = (u32x2){pq0##X.x, pq0##X.y}; *(LAS u32x2*)(b_ + O_QD + bo_ + 16) = (u32x2){pq0##X.z, pq0##X.w}; \
            *(LAS u32x2*)(b_ + O_QD + bo_ + 32) = (u32x2){pq1##X.x, pq1##X.y}; *(LAS u32x2*)(b_ + O_QD + bo_ + 48) = (u32x2){pq1##X.z, pq1##X.w}; } \
        { const int pp_ = (p##X & 32) + 8 * ((p##X >> 2) & 3) + 4 * ((p##X >> 4) & 1) + (p##X & 3); const int pos_ = ((((pp_ >> 3) ^ part##X) << 3) | (pp_ & 7)); \
            LAS bf16_t* ke_ = (LAS bf16_t*)(b_ + O_KE) + (part##X * 16) * 72 + pos_; \
            ke_[0 * 72] = (bf16_t)(pk0##X.x & 0xffffu); ke_[1 * 72] = (bf16_t)(pk0##X.x >> 16); ke_[2 * 72] = (bf16_t)(pk0##X.y & 0xffffu); ke_[3 * 72] = (bf16_t)(pk0##X.y >> 16); \
            ke_[4 * 72] = (bf16_t)(pk0##X.z & 0xffffu); ke_[5 * 72] = (bf16_t)(pk0##X.z >> 16); ke_[6 * 72] = (bf16_t)(pk0##X.w & 0xffffu); ke_[7 * 72] = (bf16_t)(pk0##X.w >> 16); \
            ke_[8 * 72] = (bf16_t)(pk1##X.x & 0xffffu); ke_[9 * 72] = (bf16_t)(pk1##X.x >> 16); ke_[10 * 72] = (bf16_t)(pk1##X.y & 0xffffu); ke_[11 * 72] = (bf16_t)(pk1##X.y >> 16); \
            ke_[12 * 72] = (bf16_t)(pk1##X.z & 0xffffu); ke_[13 * 72] = (bf16_t)(pk1##X.z >> 16); ke_[14 * 72] = (bf16_t)(pk1##X.w & 0xffffu); ke_[15 * 72] = (bf16_t)(pk1##X.w >> 16); } \
        *(LAS u32x4*)(b_ + O_T + p##X * 144 + part##X * 16) = pT##X; *(LAS u32x4*)(b_ + O_QK + p##X * 144 + part##X * 16) = pQ##X; \
        if (part##X == 0) { ((LAS float*)(b_ + O_BT))[p##X] = pbeta##X; ((LAS float*)(b_ + O_EG))[p##X] = __expf(pg##X); ((LAS float*)(b_ + O_EK))[p##X] = __expf(pglast##X - pg##X); } \
        if (slot##X == 0) ((LAS float*)(b_ + O_BT))[64] = __expf(pglast##X); } while (0)
#define SCHED() __builtin_amdgcn_sched_barrier(0)
#define LDKQ(slot, b) do { const int off_ = ((b) & 1 ? O_QD : O_KB) + rowK + 64 * ((b) >> 1); _Pragma("unroll") for (int pt = 0; pt < 4; ++pt) fA[slot][pt] = *(const LAS bf16x8*)(B + off_ + pt * 16 * 272); } while (0)
#define LDKE(slot, b) do { _Pragma("unroll") for (int tt = 0; tt < 4; ++tt) { const int t_ = 4 * ((b) & 1) + tt; fE[slot][tt] = *(const LAS bf16x8*)(B + O_KE + (16 * t_ + c16) * 144 + (((4 * ((b) >> 1) + g) ^ t_) << 4)); } } while (0)
#define COMPUTE(n) do { \
            const LAS unsigned char* B = lds + (n & 1) * BUFB; \
            const float decay = ((const LAS float*)(B + O_BT))[64]; \
            const int rowK = c16 * 272 + 16 * g, rowT = c16 * 144 + 16 * g; \
            bf16x8 Sb[4]; \
            _Pragma("unroll") \
            for (int s4 = 0; s4 < 4; ++s4) Sb[s4] = pack_b(accS[2 * s4], accS[2 * s4 + 1]); \
            f32x4 accR[4], accO[4]; \
            _Pragma("unroll") \
            for (int pt = 0; pt < 4; ++pt) { accR[pt] = (f32x4){0.f, 0.f, 0.f, 0.f}; accO[pt] = (f32x4){0.f, 0.f, 0.f, 0.f}; } \
            if (n > 0) STOREO();                            \
            bf16x8 fA[2][4]; \
            LDKQ(0, 0); \
            bf16x8 fT[6], fQK[6]; \
            _Pragma("unroll") \
            for (int b = 0; b < 8; ++b) { \
                if (b < 7) LDKQ((b + 1) & 1, b + 1); \
                else { \
                    fT[0] = *(const LAS bf16x8*)(B + O_T + rowT); fT[1] = *(const LAS bf16x8*)(B + O_T + rowT + 16 * 144); fT[2] = *(const LAS bf16x8*)(B + O_T + rowT + 32 * 144); \
                    fT[3] = *(const LAS bf16x8*)(B + O_T + rowT + 32 * 144 + 64); fT[4] = *(const LAS bf16x8*)(B + O_T + rowT + 48 * 144); fT[5] = *(const LAS bf16x8*)(B + O_T + rowT + 48 * 144 + 64); \
                } \
                SCHED(); \
                if (b & 1) { \
            _Pragma("unroll") \
                    for (int pt = 0; pt < 4; ++pt) accO[pt] = MFMA16(fA[b & 1][pt], Sb[b >> 1], accO[pt]); \
                } else { \
            _Pragma("unroll") \
                    for (int pt = 0; pt < 4; ++pt) accR[pt] = MFMA16(fA[b & 1][pt], Sb[b >> 1], accR[pt]); \
                } \
                SCHED(); \
            } \
            fQK[0] = *(const LAS bf16x8*)(B + O_QK + rowT); fQK[1] = *(const LAS bf16x8*)(B + O_QK + rowT + 16 * 144); fQK[2] = *(const LAS bf16x8*)(B + O_QK + rowT + 32 * 144); \
            fQK[3] = *(const LAS bf16x8*)(B + O_QK + rowT + 32 * 144 + 64); fQK[4] = *(const LAS bf16x8*)(B + O_QK + rowT + 48 * 144); fQK[5] = *(const LAS bf16x8*)(B + O_QK + rowT + 48 * 144 + 64); \
            _Pragma("unroll") \
            for (int pt = 0; pt < 4; ++pt) { const f32x4 bt = *(const LAS f32x4*)(B + O_BT + (16 * pt + 4 * g) * 4), eg = *(const LAS f32x4*)(B + O_EG + (16 * pt + 4 * g) * 4); \
                _Pragma("unroll") \
                for (int rg = 0; rg < 4; ++rg) { accR[pt][rg] = bt[rg] * (bf2f(pv[4 * pt + rg]) - eg[rg] * accR[pt][rg]); accO[pt][rg] *= eg[rg]; } } \
            bf16x8 Rb[2]; Rb[0] = pack_b(accR[0], accR[1]); Rb[1] = pack_b(accR[2], accR[3]); \
            if (n + 1 < nch) LOADV(n + 1); \
            f32x4 accV[4]; \
            _Pragma("unroll") \
            for (int pt = 0; pt < 4; ++pt) accV[pt] = (f32x4){0.f, 0.f, 0.f, 0.f}; \
            SCHED(); \
            accV[0] = MFMA16(fT[0], Rb[0], accV[0]); accV[1] = MFMA16(fT[1], Rb[0], accV[1]); accV[2] = MFMA16(fT[2], Rb[0], accV[2]); accV[3] = MFMA16(fT[4], Rb[0], accV[3]); \
            accV[2] = MFMA16(fT[3], Rb[1], accV[2]); accV[3] = MFMA16(fT[5], Rb[1], accV[3]); \
            SCHED(); \
            bf16x8 fE[2][4]; \
            LDKE(0, 0); \
            bf16x8 Vb[2]; Vb[0] = pack_b(accV[0], accV[1]); Vb[1] = pack_b(accV[2], accV[3]); \
            bf16x8 Ve[2]; \
            { f32x4 ev[4]; \
                _Pragma("unroll") \
                for (int pt = 0; pt < 4; ++pt) ev[pt] = accV[pt] * *(const LAS f32x4*)(B + O_EK + (16 * pt + 4 * g) * 4); \
                Ve[0] = pack_b(ev[0], ev[1]); Ve[1] = pack_b(ev[2], ev[3]); } \
            SCHED(); \
            accO[0] = MFMA16(fQK[0], Vb[0], accO[0]); accO[1] = MFMA16(fQK[1], Vb[0], accO[1]); accO[2] = MFMA16(fQK[2], Vb[0], accO[2]); accO[3] = MFMA16(fQK[4], Vb[0], accO[3]); \
            accO[2] = MFMA16(fQK[3], Vb[1], accO[2]); accO[3] = MFMA16(fQK[5], Vb[1], accO[3]); \
            _Pragma("unroll") \
            for (int t = 0; t < 8; ++t) accS[t] = accS[t] * decay; \
            _Pragma("unroll") \
            for (int b = 0; b < 4; ++b) {            \
                if (b < 3) LDKE((b + 1) & 1, b + 1); \
                SCHED(); \
            _Pragma("unroll") \
                for (int tt = 0; tt < 4; ++tt) accS[4 * (b & 1) + tt] = MFMA16(fE[b & 1][tt], Ve[b >> 1], accS[4 * (b & 1) + tt]); \
                SCHED(); \
            } \
            _Pragma("unroll") \
            for (int pt = 0; pt < 4; ++pt) { osv[2 * pt] = pk(accO[pt][0], accO[pt][1]); osv[2 * pt + 1] = pk(accO[pt][2], accO[pt][3]); } \
            gprev = gcur; \
        } while (0)
    if (lat && wave >= 4) {
        LOADG(0, A); LOADG(0, B); FILL(0, A); FILL(0, B); LOADG(1, A); LOADG(1, B);
        __syncthreads();
        for (int n = 0; n < nch; ++n) {
            if (n + 1 < nch) { FILL((n + 1) & 1, A); FILL((n + 1) & 1, B); }
            if (n + 2 < nch) { LOADG(n + 2, A); LOADG(n + 2, B); }
            __syncthreads();
        }
    } else if (lat) {
        f32x4 accS[8];
#pragma unroll
        for (int t = 0; t < 8; ++t)
#pragma unroll
            for (int reg = 0; reg < 4; ++reg) { const int dk = 16 * t + 4 * g + reg; accS[t][reg] = a.state[((size_t)(((sidx * 2 + l) * 2 + d) * 4 + h) * 128 + dk) * 128 + dv]; }
        LOADV(0);
        __syncthreads();
        for (int n = 0; n < nch; ++n) {
            const unsigned gcur = (unsigned)((r0 >> 6) + (d ? nch - 1 - n : n));
            COMPUTE(n);
            __syncthreads();
        }
        STOREO();
    } else {
        f32x4 accS[8];
#pragma unroll
        for (int t = 0; t < 8; ++t) accS[t] = (f32x4){0.f, 0.f, 0.f, 0.f};
        LOADG(0, A); LOADV(0); FILL(0, A);
        __syncthreads();
        for (int n = 0; n < nch; ++n) {
            const unsigned gcur = (unsigned)((r0 >> 6) + (d ? nch - 1 - n : n));
            if (n + 1 < nch) { LOADG(n + 1, A); FILL((n + 1) & 1, A); }
            COMPUTE(n);
            __syncthreads();
        }
        STOREO();
        { float* ns = a.out + (size_t)MTOK * 1024 + (size_t)(((sidx * 2 + l) * 2 + d) * 4 + h) * 16384;
#pragma unroll
            for (int t = 0; t < 8; ++t)
#pragma unroll
                for (int reg = 0; reg < 4; ++reg) { const int dk = 16 * t + 4 * g + reg; ns[dk * 128 + dv] = accS[t][reg]; } }
    }
#undef COMPUTE
#undef LDKQ
#undef LDKE
#undef SCHED
#undef STOREO
    if (!lat) { __syncthreads(); ph_prologue(wv, l, lds, 4, 128, 128); }
#undef LOADG
#undef LOADV
#undef FILL
}

__device__ __forceinline__ void ph_mix_prep(const int wv, const int l) {
    const Args a = load_args();
    const int tid = opq_tid(wv), lane = tid & 63, wave = __builtin_amdgcn_readfirstlane(tid >> 6); const int bid = opq_bid();
    const int gw = bid * 8 + wave, NGW = gridDim.x * 8;
    const bf16_t* OF = (const bf16_t*)(a.ws + WS_OF); const bf16_t* OB = (const bf16_t*)(a.ws + WS_OB); const bf16_t* ZG = (const bf16_t*)(a.ws + WS_ZG);
    bf16_t* A = (bf16_t*)(a.ws + WS_H);
    float onw[8]; load8f(a.o_norm_w + l * 128 + (lane & 15) * 8, onw);
    const int c = lane * 8;
    for (int rowb = gw; rowb < MTOK; rowb += 8 * NGW) {
        u32x4 lf[8], lb[8], lg[8];
#pragma unroll
        for (int u = 0; u < 8; ++u) { const int row = rowb + u * NGW; if (row < MTOK) { lf[u] = *(const u32x4*)(OF + (size_t)row * 512 + c); lb[u] = *(const u32x4*)(OB + (size_t)row * 512 + c); lg[u] = *(const u32x4*)(ZG + (size_t)row * 512 + c); } }
#pragma unroll
        for (int u = 0; u < 8; ++u) { const int row = rowb + u * NGW; if (row < MTOK) {
            float f[8], b[8], g[8], y[8];
            unpack8(lf[u], f); unpack8(lb[u], b); unpack8(lg[u], g);
            float ss = 0.f;
#pragma unroll
            for (int e = 0; e < 8; ++e) { f[e] += b[e]; ss += f[e] * f[e]; }
            ss += __shfl_xor(ss, 1); ss += __shfl_xor(ss, 2); ss += __shfl_xor(ss, 4); ss += __shfl_xor(ss, 8);
            const float rstd = rsqrtf(ss * (1.f / 128.f) + EPS);
#pragma unroll
            for (int e = 0; e < 8; ++e) y[e] = f[e] * rstd * onw[e] * silu_f(g[e]);
            *(u32x4*)(A + (size_t)row * 1024 + 512 + c) = pack8(y); } }
    }
}

__device__ __forceinline__ void ph_act(const int wv, const int l, const int half) {
    const Args a = load_args();
    const int tid = opq_tid(wv); const int bid = opq_bid(); const int hb = half * 10240;
    const bf16_t* UP = (const bf16_t*)(a.ws + WS_UP); bf16_t* ACT = (bf16_t*)(a.ws + WS_ACT);
    const float* cw = a.ffn_conv_w + (size_t)l * 9 * 2816;
    const u32x4 zero4 = {0u, 0u, 0u, 0u};
    const int xg = bid & 7, nloc = (int)(gridDim.x >> 3) * 512;
    for (int itl = (bid >> 3) * 512 + tid; itl < 640 * 44; itl += nloc) {
        const int seg = itl / 44, wch = itl % 44, c = (xg * 44 + wch) * 8; const int rs = hb + seg * 16;
        const bf16_t* UPb = UP + (size_t)xg * ((size_t)10240 * 704);
        int pos0, rl; bool up_ok, dn_ok;
        if (rs < 4096) { pos0 = rs & 255; rl = 256; up_ok = false; dn_ok = false; }
        else { const int ts = (rs - 4096) & 2047, gr = ts >> 6; pos0 = ts & 63; rl = 64; up_ok = gr > 0; dn_ok = gr < 31; }
        const bf16_t* g0 = UPb + (size_t)(rs - hb) * 704 + 352 + wch * 8;
        float w[3][3][8];
#pragma unroll
        for (int dr = 0; dr < 3; ++dr)
#pragma unroll
            for (int dc = 0; dc < 3; ++dc) load8f(cw + (dr * 3 + dc) * 2816 + c, w[dr][dc]);
        u32x4 col[20][3]; u32x4 us[16];
#define LOADCOL(X, t) do { const int ps_ = pos0 + (t); const bool ok_ = ps_ >= 0 && ps_ < rl; const bf16_t* gp_ = g0 + (ptrdiff_t)(t) * 704; \
        X[1] = ok_ ? *(const u32x4*)gp_ : zero4; X[0] = (ok_ && up_ok) ? *(const u32x4*)(gp_ - 64 * 704) : zero4; X[2] = (ok_ && dn_ok) ? *(const u32x4*)(gp_ + 64 * 704) : zero4; } while (0)
        const bf16_t* u0 = UPb + (size_t)(rs - hb) * 704 + wch * 8;
        LOADCOL(col[0], -1); LOADCOL(col[1], 0); LOADCOL(col[2], 1);
        us[0] = *(const u32x4*)u0; us[1] = *(const u32x4*)(u0 + 704);
#pragma unroll
        for (int t = 0; t < 16; ++t) { if (t + 2 <= 16) LOADCOL(col[t + 3], t + 2);
            if (t + 2 < 16) us[t + 2] = *(const u32x4*)(u0 + (size_t)(t + 2) * 704);
            float s[8];
#pragma unroll
            for (int e = 0; e < 8; ++e) s[e] = 0.f;
#pragma unroll
            for (int dr = 0; dr < 3; ++dr) { float fa[8], fb[8], fc[8]; unpack8(col[t][dr], fa); unpack8(col[t + 1][dr], fb); unpack8(col[t + 2][dr], fc);
#pragma unroll
                for (int e = 0; e < 8; ++e) s[e] += w[dr][0][e] * fa[e] + w[dr][1][e] * fb[e] + w[dr][2][e] * fc[e]; }
            float fu[8], y[8]; unpack8(us[t], fu);
#pragma unroll
            for (int e = 0; e < 8; ++e) { const float x = s[e], z = 0.7978845608028654f * (x + 0.044715f * x * x * x); y[e] = x / (1.f + __expf(-2.f * z)) * fu[e]; }
            *(u32x4*)(ACT + (size_t)(rs - hb + t) * 2816 + c) = pack8(y);
            asm volatile("" ::: "memory"); }
#undef LOADCOL
    }
}

__device__ __forceinline__ void ph_final(const int wv) {
    const Args a = load_args();
    const int tid = opq_tid(wv), lane = tid & 63, wave = __builtin_amdgcn_readfirstlane(tid >> 6); const int bid = opq_bid();
    const int gw = bid * 8 + wave, NGW = gridDim.x * 8;
    f32x4 nwv[4];
#pragma unroll
    for (int j = 0; j < 4; ++j) nwv[j] = *(const f32x4*)(a.final_norm_w + 4 * (lane + 64 * j));
    for (int rowb = gw; rowb < MTOK; rowb += 4 * NGW) {
        f32x4 v[4][4];
#pragma unroll
        for (int u = 0; u < 4; ++u) { const int row = rowb + u * NGW; if (row < MTOK) {
#pragma unroll
            for (int j = 0; j < 4; ++j) v[u][j] = *(const f32x4*)(a.out + (size_t)row * 1024 + 4 * (lane + 64 * j)); } }
#pragma unroll
        for (int u = 0; u < 4; ++u) { const int row = rowb + u * NGW; if (row < MTOK) { float ss = 0.f;
#pragma unroll
            for (int j = 0; j < 4; ++j) ss += (v[u][j].x * v[u][j].x + v[u][j].y * v[u][j].y) + (v[u][j].z * v[u][j].z + v[u][j].w * v[u][j].w);
            const float rstd = rsqrtf(wave_sum(ss) * (1.f / 1024.f) + EPS);
#pragma unroll
            for (int j = 0; j < 4; ++j) *(f32x4*)(a.out + (size_t)row * 1024 + 4 * (lane + 64 * j)) = v[u][j] * rstd * nwv[j]; } }
    }
}

__global__ void __launch_bounds__(512, 2) mega_fwd(Args a_unused) {
    extern __shared__ __attribute__((aligned(16))) unsigned char lds_raw[];
    LAS unsigned char* lds = (LAS unsigned char*)lds_raw;
    cg::grid_group grid = cg::this_grid();
    const int G = gridDim.x;
    const int wv = __builtin_amdgcn_readfirstlane((int)threadIdx.x >> 6);
    XcdBarrier bar;
    {
        const Args a0 = load_args(); unsigned* barw = (unsigned*)(a0.ws + WS_BAR);
        volatile LAS unsigned* st = (volatile LAS unsigned*)(lds + 147440);
        const int tid0 = opq_tid(wv);
        if (tid0 == 0) { st[0] = 0u; st[1] = 0u; }
        __syncthreads();
        bar = xcd_barrier_post(barw, st, wv);
        if (G == 0x7fffffff) grid.sync();
        if (PHMASK & 1) ph_prologue(wv, 0, lds, 3, 0, G);
        xcd_barrier(bar);
    }
#define SEAM() xcd_barrier(bar)
#pragma unroll 1
    for (int l = 0; l < 2; ++l) {
        if (l > 0) { if (PHMASK & 1) ph_prologue(wv, l, lds, 2, 0, G); SEAM(); }
        for (int rp_ = 0; rp_ < REP_PH1; ++rp_) { if (PHMASK & 2) ph_prep_h(wv, l, 1, lds); SEAM(); }
        for (int rg_ = 0; rg_ < REP_GIN; ++rg_) { if (rg_ > 0) SEAM();
        if (PHMASK & 4) { const Args a = load_args(); pg8::Gemm g{(const bf16_t*)(a.ws + WS_H), (const bf16_t*)(a.ws + WS_WIN), MTOK, 3840, 1024}; pg8::StaticOrder S; S.init(MTOK, 3840, G, opq_bid());
            pg8::EpiIn E{(bf16_t*)(a.ws + WS_CB), (bf16_t*)(a.ws + WS_P), (bf16_t*)(a.ws + WS_ZQ), (bf16_t*)(a.ws + WS_ZG), (float*)(a.ws + WS_BA)};
            pg8::gemm_phase<pg8::EpiIn, pg8::StaticOrder, true, true>(lds, g, S, E, opq_tid(wv)); } }
        SEAM();
        for (int rp_ = 0; rp_ < REP_CV; ++rp_) { if (PHMASK & 8) ph_conv_prep(wv, l); SEAM(); }
        for (int rp_ = 0; rp_ < REP_PRE; ++rp_) { if (PHMASK & 16) ph_pre(wv, l, lds); SEAM(); }
        for (int rp_ = 0; rp_ < REP_SCAN; ++rp_) { if (PHMASK & 32) ph_scan(wv, l, lds); SEAM(); }
        for (int rp_ = 0; rp_ < REP_MX; ++rp_) { if (PHMASK & 64) ph_mix_prep(wv, l); SEAM(); }
        if (PHMASK & 128) { const Args a = load_args(); const float* MOD = (const float*)(a.ws + WS_MOD); pg8::Gemm g{(const bf16_t*)(a.ws + WS_H), (const bf16_t*)(a.ws + WS_WOUT), MTOK, 1024, 1024}; pg8::StaticOrder S; S.init(MTOK, 1024, G, opq_bid());
            pg8::EpiRes E{l == 0 ? a.x_prompt : a.out, l == 0 ? a.x_sample : a.out + (size_t)4096 * 1024, a.out, MOD + (size_t)l * 9 * 6144 + 2048, 0};
            pg8::gemm_phase<pg8::EpiRes, pg8::StaticOrder, true, true>(lds, g, S, E, opq_tid(wv)); }
        SEAM();
        for (int rp_ = 0; rp_ < REP_PH2; ++rp_) { if (PHMASK & 256) ph_prep_h(wv, l, 2, lds); SEAM(); }
#pragma unroll 1
        for (int half = 0; half < 2; ++half) {
            if (PHMASK & 512) { const Args a = load_args(); pg8::Gemm g{(const bf16_t*)(a.ws + WS_H) + (size_t)half * 10240 * 1024, (const bf16_t*)(a.ws + WS_WUP), 10240, 5632, 1024}; pg8::FlexOrder S; S.init(10240, 5632, G, opq_bid(), (half == 1 && G == 256) ? 160 : 0, 3);
                pg8::EpiUp E{(bf16_t*)(a.ws + WS_UP), 5632};
                pg8::gemm_phase<pg8::EpiUp, pg8::FlexOrder, true, true>(lds, g, S, E, opq_tid(wv)); }
            SEAM();
            for (int rp_ = 0; rp_ < REP_ACT; ++rp_) { if (PHMASK & 1024) ph_act(wv, l, half); SEAM(); }
            for (int rp_ = 0; rp_ < REP_SYNC; ++rp_) SEAM();
            if (PHMASK & 2048) { const Args a = load_args(); const float* MOD = (const float*)(a.ws + WS_MOD); pg8::Gemm g{(const bf16_t*)(a.ws + WS_ACT), (const bf16_t*)(a.ws + WS_WDN), 10240, 1024, 2816}; pg8::StaticOrder S; S.init(10240, 1024, G, opq_bid());
                pg8::EpiRes E{a.out, a.out + (size_t)4096 * 1024, a.out, MOD + (size_t)l * 9 * 6144 + 5120, half * 10240};
                pg8::gemm_phase<pg8::EpiRes, pg8::StaticOrder, true, true>(lds, g, S, E, opq_tid(wv)); }
            if (half == 1 && l == 1) SEAM();
        }
    }
    if (PHMASK & 4096) ph_final(wv);
}

extern "C" void kernel_launch(void* const* d_in, const int* in_sizes, int n_in, void* d_out, int out_size, void* d_ws, size_t ws_size, hipStream_t stream) {
    static int grid = 0;
    if (grid == 0) {
        int dev = 0, cus = 0;
        if (hipGetDevice(&dev) != hipSuccess || hipDeviceGetAttribute(&cus, hipDeviceAttributeMultiprocessorCount, dev) != hipSuccess) { fprintf(stderr, "kernel_launch: device query failed\n"); grid = -1; return; }
        if (hipFuncSetAttribute((const void*)mega_fwd, hipFuncAttributeMaxDynamicSharedMemorySize, LDS_BYTES) != hipSuccess) { fprintf(stderr, "kernel_launch: hipFuncSetAttribute failed\n"); grid = -1; return; }
        int per_cu = 0;
        if (hipOccupancyMaxActiveBlocksPerMultiprocessor(&per_cu, (const void*)mega_fwd, 512, LDS_BYTES) != hipSuccess || per_cu < 1) fprintf(stderr, "kernel_launch: occupancy query says %d blocks/CU\n", per_cu);
        (void)hipGetLastError();
        grid = cus;
        if (n_in != 20 || ws_size < (size_t)250 * MiB) { fprintf(stderr, "kernel_launch: unexpected n_in %d / ws_size %zu\n", n_in, ws_size); }
    }
    if (grid < 0) return;
    Args a{};
    const float** pa = (const float**)&a;
    for (int i = 0; i < 20; ++i) pa[i] = (const float*)d_in[i];
    a.out = (float*)d_out; a.ws = (unsigned char*)d_ws;
    (void)hipMemsetAsync((unsigned char*)d_ws + WS_BAR, 0, (size_t)XCD_BAR_WORDS * 4, stream);
    void* args[] = {&a};
    hipError_t e = hipLaunchCooperativeKernel((const void*)mega_fwd, dim3(grid), dim3(512), args, LDS_BYTES, stream);
    if (e != hipSuccess) fprintf(stderr, "cooperative launch failed: %s (grid %d)\n", hipGetErrorString(e), grid);
}
```
